# Optimizing an MI355X kernel written in HIP

```python
import math
import jax, jax.numpy as jnp
from jax import lax
import numpy as np

D_MODEL = 1024
BATCH = 4
SEQ = 8192
DEPTH = 1

CONV_WIDTH = D_MODEL
CONV_K = 3
HEAD_DIM = 64
N_HEADS = 16
N_KV_HEADS = 4
GROUP = N_HEADS // N_KV_HEADS
ATTN_WIDTH = N_HEADS * HEAD_DIM
KV_WIDTH = N_KV_HEADS * HEAD_DIM
WINDOW = 128
BLOCK = 128
N_GROUPS = 4
EXPERTS_PER_GROUP = 8
N_EXPERTS = N_GROUPS * EXPERTS_PER_GROUP
TOP_K = 2
D_FF_EXPERT = 512
EPS = 1e-6

SPLIT_SIZES = [CONV_WIDTH, CONV_WIDTH, CONV_WIDTH,
               ATTN_WIDTH, KV_WIDTH, KV_WIDTH,
               D_MODEL, D_MODEL]
SPLITS = np.cumsum(SPLIT_SIZES)[:-1].tolist()
IN_COLS = int(sum(SPLIT_SIZES))

kernel_name = "hybrid_conv_swa_alibi_hmoe_block"


def rmsnorm(x, g):
    xf = x.astype(jnp.float32)
    r = lax.rsqrt(jnp.mean(xf * xf, axis=-1, keepdims=True) + EPS)
    return (xf * r).astype(x.dtype) * g


def alibi_slopes():
    return jnp.exp2(-8.0 * jnp.arange(1, N_HEADS + 1, dtype=jnp.float32) / N_HEADS)


def short_conv_mixer(b_gate, c_gate, u, conv_w, conv_b):
    cu = c_gate * u
    rhs = conv_w[:, None, :].astype(cu.dtype)
    y = lax.conv_general_dilated(cu, rhs, window_strides=(1,), padding=[(CONV_K - 1, 0)],
                                 dimension_numbers=('NWC', 'WIO', 'NWC'),
                                 feature_group_count=CONV_WIDTH)
    return b_gate * (y + conv_b)


def sliding_window_gqa(q, k, v, sinks):
    bsz, s = q.shape[0], q.shape[1]
    n = s // BLOCK
    qb = q.reshape(bsz, n, BLOCK, N_KV_HEADS, GROUP, HEAD_DIM)
    kb = k.reshape(bsz, n, BLOCK, N_KV_HEADS, HEAD_DIM)
    vb = v.reshape(bsz, n, BLOCK, N_KV_HEADS, HEAD_DIM)
    pad = ((0, 0), (1, 0), (0, 0), (0, 0), (0, 0))
    kw = jnp.concatenate([jnp.pad(kb, pad)[:, :-1], kb], axis=2)
    vw = jnp.concatenate([jnp.pad(vb, pad)[:, :-1], vb], axis=2)
    logits = jnp.einsum('bnqkgd,bnskd->bnkgqs', qb, kw).astype(jnp.float32)
    logits = logits * (1.0 / math.sqrt(HEAD_DIM))
    qi = jnp.arange(BLOCK)[:, None]
    sj = jnp.arange(2 * BLOCK)[None, :]
    dist = (qi - sj + BLOCK).astype(jnp.float32)
    key_pos = jnp.arange(n)[:, None] * BLOCK - BLOCK + sj
    valid = ((dist >= 0) & (dist < WINDOW))[None] & (key_pos >= 0)[:, None, :]
    slopes = alibi_slopes().reshape(N_KV_HEADS, GROUP)
    logits = logits - slopes[:, :, None, None] * dist
    logits = jnp.where(valid[None, :, None, None], logits, -jnp.inf)
    sink = sinks.astype(jnp.float32).reshape(N_KV_HEADS, GROUP)[None, None, :, :, None, None]
    m = jnp.maximum(jnp.max(logits, axis=-1, keepdims=True), sink)
    p = jnp.exp(logits - m)
    denom = jnp.sum(p, axis=-1, keepdims=True) + jnp.exp(sink - m)
    probs = (p / denom).astype(v.dtype)
    out = jnp.einsum('bnkgqs,bnskd->bnqkgd', probs, vw)
    return out.reshape(bsz, s, ATTN_WIDTH)


def hierarchical_moe(h, w_group, b_group, w_expert, b_expert, w_gate, w_up, w_down):
    bsz, s, d = h.shape
    t = bsz * s
    hf = h.reshape(t, d)
    gl = (hf @ w_group + b_group).astype(jnp.float32)
    gp = jax.nn.softmax(gl, axis=-1)
    g_idx = jnp.argmax(gl, axis=-1)
    p_g = jnp.take_along_axis(gp, g_idx[:, None], axis=-1)
    el = (hf @ w_expert + b_expert).astype(jnp.float32).reshape(t, N_GROUPS, EXPERTS_PER_GROUP)
    sel = jnp.take_along_axis(el, g_idx[:, None, None], axis=1)[:, 0]
    top_v, top_i = lax.top_k(sel, TOP_K)
    weights = p_g * jax.nn.softmax(top_v, axis=-1)
    expert_id = (g_idx[:, None] * EXPERTS_PER_GROUP + top_i).reshape(-1)
    order = jnp.argsort(expert_id)
    token_of = order // TOP_K
    sizes = jnp.bincount(expert_id, length=N_EXPERTS).astype(jnp.int32)
    xs = hf[token_of]
    a = lax.ragged_dot(xs, w_gate, sizes)
    b = lax.ragged_dot(xs, w_up, sizes)
    out = lax.ragged_dot(jax.nn.silu(a) * b, w_down, sizes)
    w_sorted = weights.reshape(-1)[order].astype(out.dtype)
    y = jnp.zeros((t, d), out.dtype).at[token_of].add(out * w_sorted[:, None])
    return y.reshape(bsz, s, d)


def setup_inputs(seed: int = 0) -> dict:
    key = jax.random.key(seed)
    ks = jax.random.split(key, 20)
    f32 = jnp.float32

    def nrm(k, shape, fan_in):
        return jax.random.normal(k, shape, f32) * (fan_in ** -0.5)

    def gain(k, n):
        return 1.0 + 0.02 * jax.random.normal(k, (n,), f32)

    return {
        "x": jax.random.normal(ks[0], (BATCH, SEQ, D_MODEL), f32),
        "norm_mix": gain(ks[1], D_MODEL),
        "w_in": nrm(ks[2], (D_MODEL, IN_COLS), D_MODEL),
        "conv_w": nrm(ks[3], (CONV_K, CONV_WIDTH), CONV_K),
        "conv_b": 0.02 * jax.random.normal(ks[4], (CONV_WIDTH,), f32),
        "w_a_out": nrm(ks[5], (CONV_WIDTH, D_MODEL), CONV_WIDTH),
        "sinks": 0.5 * jax.random.normal(ks[6], (N_HEADS,), f32),
        "w_b_out": nrm(ks[7], (ATTN_WIDTH, D_MODEL), ATTN_WIDTH),
        "w_o": nrm(ks[8], (D_MODEL, D_MODEL), D_MODEL),
        "norm_ffn": gain(ks[9], D_MODEL),
        "w_group": nrm(ks[10], (D_MODEL, N_GROUPS), D_MODEL),
        "b_group": 0.01 * jax.random.normal(ks[11], (N_GROUPS,), f32),
        "w_expert": nrm(ks[12], (D_MODEL, N_EXPERTS), D_MODEL),
        "b_expert": 0.01 * jax.random.normal(ks[13], (N_EXPERTS,), f32),
        "w_gate": nrm(ks[14], (N_EXPERTS, D_MODEL, D_FF_EXPERT), D_MODEL),
        "w_up": nrm(ks[15], (N_EXPERTS, D_MODEL, D_FF_EXPERT), D_MODEL),
        "w_down": nrm(ks[16], (N_EXPERTS, D_FF_EXPERT, D_MODEL), D_FF_EXPERT),
        "norm_final": gain(ks[17], D_MODEL),
    }


def reference(x, norm_mix, w_in, conv_w, conv_b, w_a_out, sinks, w_b_out, w_o,
              norm_ffn, w_group, b_group, w_expert, b_expert, w_gate, w_up, w_down,
              norm_final):
    bsz, s, _ = x.shape
    for _layer in range(DEPTH):
        h = rmsnorm(x, norm_mix)
        proj = h @ w_in
        b_gate, c_gate, u, q, k, v, g_a, g_b = jnp.split(proj, SPLITS, axis=-1)
        y_a = short_conv_mixer(b_gate, c_gate, u, conv_w, conv_b) @ w_a_out
        attn = sliding_window_gqa(q.reshape(bsz, s, N_HEADS, HEAD_DIM),
                                  k.reshape(bsz, s, N_KV_HEADS, HEAD_DIM),
                                  v.reshape(bsz, s, N_KV_HEADS, HEAD_DIM), sinks)
        y_b = attn @ w_b_out
        merged = jax.nn.sigmoid(g_a) * y_a + jax.nn.sigmoid(g_b) * y_b
        x = x + merged @ w_o
        x = x + hierarchical_moe(rmsnorm(x, norm_ffn), w_group, b_group, w_expert,
                                 b_expert, w_gate, w_up, w_down)
    return rmsnorm(x, norm_final)
```

```cpp
#include <hip/hip_runtime.h>
#include <hip/hip_cooperative_groups.h>
#include <cstdio>
#include <cstdint>
namespace cg = cooperative_groups;

#ifndef MK_N_LAUNCHES
#define MK_N_LAUNCHES 9
#endif
constexpr int N_LAUNCHES = MK_N_LAUNCHES;
constexpr int N_PHASES = 9;

#define GAS __attribute__((address_space(1)))
#define LAS __attribute__((address_space(3)))
typedef unsigned short bf16;
typedef short bf16x8 __attribute__((ext_vector_type(8)));
typedef short s16x4 __attribute__((ext_vector_type(4)));
typedef float f32x4 __attribute__((ext_vector_type(4)));
typedef float f32x2 __attribute__((ext_vector_type(2)));
typedef float f32x16 __attribute__((ext_vector_type(16)));
typedef unsigned u32x4 __attribute__((ext_vector_type(4)));
typedef unsigned u32x2 __attribute__((ext_vector_type(2)));
typedef GAS unsigned gu32;

constexpr int D = 1024, BATCH = 4, SEQ = 8192, M = BATCH * SEQ;
constexpr int NCOL = 6656, NHEAD = 16, HD = 64, NKV = 4, KVW = 256;
constexpr int NEXP = 32, NGRP = 4, EPG = 8, FF = 512, CAP = 32768;
constexpr float EPS = 1e-6f;
constexpr float LOG2E = 1.4426950408889634f;
constexpr float QSCALE = 0.125f * LOG2E;
constexpr int NWAVES = 8;

constexpr size_t MiB = 1u << 20;
constexpr size_t WS_CTL = 0, CTL_ZERO_BYTES = 1 * MiB;
constexpr size_t WS_RWF = 1 * MiB;
constexpr size_t WS_WIN = 2 * MiB;
constexpr size_t WS_WA = 15 * MiB, WS_WB = 17 * MiB, WS_WO = 19 * MiB;
constexpr size_t WS_WGU = 21 * MiB;
constexpr size_t WS_WD = 85 * MiB;
constexpr size_t WS_LTOK = 117 * MiB, WS_LR = 121 * MiB, WS_LW = 125 * MiB;
constexpr size_t WS_H = 129 * MiB;
constexpr size_t WS_B = 193 * MiB;
constexpr size_t WS_CU = 257 * MiB;
constexpr size_t WS_K = 321 * MiB, WS_V = 337 * MiB;
constexpr size_t WS_GB = 353 * MiB;
constexpr size_t WS_PAIRS = 321 * MiB;
constexpr size_t WS_END = 449 * MiB;

constexpr int CW_TMO = 0;
constexpr int CW_CNT = 64;
constexpr int CW_BAR = 4096;

constexpr int RING_BYTES = 131072;
constexpr int LDSCTL_OFF = RING_BYTES, MISC_OFF = LDSCTL_OFF + 320, PFX_OFF = LDSCTL_OFF + 512;
constexpr int LDS_BYTES = 147456;

#define RLX_AGENT __ATOMIC_RELAXED, __HIP_MEMORY_SCOPE_AGENT
#define LDS_WAIT() asm volatile("s_waitcnt lgkmcnt(0)" ::: "memory")
#define VM_WAIT() asm volatile("s_waitcnt vmcnt(0)" ::: "memory")
__device__ __forceinline__ unsigned f2bf(float f) { unsigned u = __builtin_bit_cast(unsigned, f); return (u + 0x7fffu + ((u >> 16) & 1u)) >> 16; }
__device__ __forceinline__ unsigned pk2(float lo, float hi) { return f2bf(lo) | (f2bf(hi) << 16); }
__device__ __forceinline__ float bf2f(unsigned short b) { return __builtin_bit_cast(float, (unsigned)b << 16); }
__device__ __forceinline__ float bflo(unsigned w) { return __builtin_bit_cast(float, w << 16); }
__device__ __forceinline__ float bfhi(unsigned w) { return __builtin_bit_cast(float, w & 0xffff0000u); }
__device__ __forceinline__ unsigned cvt_pk_bf16(float lo, float hi) { unsigned r; asm volatile("v_cvt_pk_bf16_f32 %0, %1, %2" : "=v"(r) : "v"(lo), "v"(hi)); return r; }
__device__ __forceinline__ float fast_sigmoid(float x) { return __builtin_amdgcn_rcpf(1.0f + __builtin_amdgcn_exp2f(-LOG2E * x)); }

#define XB_TMO      128
#define XB_XCNT(j)  (256  + 64 * (j))
#define XB_XSUB(j)  (1280 + 64 * (j))
#define XB_XGEN(j)  (2304 + 64 * (j))
#define XB_TOP      3328
#define XB_TOPGEN   3392
#define XCD_BAR_WORDS 3456
#define XB_SPIN_CAP (1u << 18)
__device__ __forceinline__ unsigned xb_ld(unsigned* p)              { return __hip_atomic_load(p, __ATOMIC_RELAXED, __HIP_MEMORY_SCOPE_AGENT); }
__device__ __forceinline__ unsigned xb_add(unsigned* p, unsigned v) { return __hip_atomic_fetch_add(p, v, __ATOMIC_RELAXED, __HIP_MEMORY_SCOPE_AGENT); }
__device__ __forceinline__ unsigned xb_xcc_id() { return (unsigned)__builtin_amdgcn_s_getreg((3 << 11) | 20) & 0xFu; }
#define XB_SPIN(cond, bar) do { unsigned _sp = 0; while (cond) { __builtin_amdgcn_s_sleep(1); \
    if ((++_sp & 255u) == 0u) { if (xb_ld(&(bar)[XB_TMO])) break; if (_sp > XB_SPIN_CAP) { atomicAdd(&(bar)[XB_TMO], 1u); break; } } } } while (0)
struct XcdBarrier { unsigned* bar; unsigned x; volatile LAS unsigned* st; };
__device__ __forceinline__ XcdBarrier xcd_barrier_post(unsigned* bar, volatile LAS unsigned* st) {
    XcdBarrier b; b.bar = bar; b.x = xb_xcc_id(); b.st = st;
    if (threadIdx.x == 0) (void)xb_add(&bar[XB_XCNT(b.x)], 1u);
    return b;
}
__device__ __forceinline__ void xcd_barrier_complete(unsigned* bar, unsigned x, unsigned& nloc, unsigned& nx) {
    const unsigned G = gridDim.x * gridDim.y * gridDim.z;
    unsigned sum, cnt, mine, sp = 0u;
    for (;;) {
        sum = 0u; cnt = 0u; mine = 0u;
#pragma unroll
        for (unsigned j = 0; j < 16; ++j) { const unsigned c = xb_ld(&bar[XB_XCNT(j)]); sum += c; cnt += (c > 0u) ? 1u : 0u; mine = (j == x) ? c : mine; }
        if (sum == G) break;
        __builtin_amdgcn_s_sleep(1);
        if ((++sp & 255u) == 0u) { if (xb_ld(&bar[XB_TMO])) break; if (sp > XB_SPIN_CAP) { atomicAdd(&bar[XB_TMO], 1u); break; } }
    }
    nloc = mine > 0u ? mine : 1u; nx = cnt > 0u ? cnt : 1u;
}
__device__ __forceinline__ void xcd_barrier(const XcdBarrier& b) {
    asm volatile("s_waitcnt vmcnt(0)" ::: "memory");
    __syncthreads();
    if (threadIdx.x == 0) {
        unsigned* bar = b.bar;
        __builtin_amdgcn_s_waitcnt(0);
        unsigned nloc = b.st[0], nx = b.st[1];
        if (nloc == 0u) { xcd_barrier_complete(bar, b.x, nloc, nx); b.st[0] = nloc; b.st[1] = nx; }
        const unsigned old = xb_add(&bar[XB_XSUB(b.x)], 1u);
        const unsigned gen = old / nloc;
        if (old + 1u == (gen + 1u) * nloc) {
            __builtin_amdgcn_fence(__ATOMIC_RELEASE, "agent");
            asm volatile("s_waitcnt vmcnt(0)" ::: "memory");
            const unsigned og = xb_add(&bar[XB_TOP], 1u);
            const unsigned tg = og / nx;
            if (og + 1u == (tg + 1u) * nx) xb_add(&bar[XB_TOPGEN], 1u);
            else XB_SPIN(xb_ld(&bar[XB_TOPGEN]) == tg, bar);
            __builtin_amdgcn_fence(__ATOMIC_ACQUIRE, "agent");
            xb_add(&bar[XB_XGEN(b.x)], 1u);
            asm volatile("s_waitcnt vmcnt(0)" ::: "memory");
        } else {
            XB_SPIN(xb_ld(&bar[XB_XGEN(b.x)]) == gen, bar);
            __builtin_amdgcn_fence(__ATOMIC_ACQUIRE, "agent");
            asm volatile("s_waitcnt vmcnt(0)" ::: "memory");
        }
    }
    __syncthreads();
}

namespace pg8 {
constexpr int BM = 256, BK = 64, HALF = 128, HTB = HALF * BK * 2, NXCD = 8, WGM = 8;
__host__ __device__ __forceinline__ int lds_byte(int r, int c) { const int st = (r >> 4) * 2 + (c >> 5), rr = r & 15, cc = c & 31, ob = rr * 64 + cc * 2; return st * 1024 + (ob ^ (((ob >> 9) & 1) << 5)); }
__host__ __device__ __forceinline__ void stage_rc(int b, int& R, int& C) { const int st = b / 1024, sb = b % 1024, swz = sb ^ (((sb >> 9) & 1) << 5); R = (st >> 1) * 16 + swz / 64; C = (st & 1) * 32 + (swz % 64) / 2; }
__host__ __device__ __forceinline__ int perm32(int rho) { const int n = rho >> 4, i = rho & 15; return 8 * (i >> 2) + 4 * n + (i & 3); }

struct Unit { int pm, pn, x0, x1, x2; };
__device__ __forceinline__ bool static_unit(long L, int nM, int nN, int& pm, int& pn) {
    const int nwg = nM * nN; if (L >= nwg) return false;
    int wgid = (int)L; { const int q = nwg / NXCD, r = nwg % NXCD, xcd = wgid % NXCD, off = wgid / NXCD; wgid = (xcd < r ? xcd * (q + 1) : r * (q + 1) + (xcd - r) * q) + off; }
    const int nig = WGM * nN, gid = wgid / nig, fm = gid * WGM, gsz = (nM - fm) < WGM ? (nM - fm) : WGM;
    pm = fm + ((wgid % nig) % gsz); pn = (wgid % nig) / gsz; return true;
}

template <class Epi, class Sched, bool GATHER>
__device__ __forceinline__ void gemm_phase(LAS unsigned char* lds, const int K, const Sched& S, const Epi& E) {
    const int tid = threadIdx.x, wid = __builtin_amdgcn_readfirstlane(tid >> 6), lane = tid & 63, wr = wid >> 2, wc = wid & 3, fr = lane & 15, fq = lane >> 4;
    const int nt = K / BK;
    const size_t kstep = (size_t)(BK * 2);
    const size_t hstep = (size_t)HALF * K * 2;
    unsigned voffB[2], aoC[2][2], aoN[2][2]; int Rl[2], Cb[2];
#pragma unroll
    for (int i = 0; i < 2; ++i) { int R, C; stage_rc(tid * 16 + i * 8192, R, C); const int Rb = (R & ~31) + perm32(R & 31);
        voffB[i] = (unsigned)(Rb * K + C) * 2u; Rl[i] = R; Cb[i] = C * 2;
        aoC[0][i] = (unsigned)(R * K + C) * 2u; aoC[1][i] = aoC[0][i] + (unsigned)hstep; aoN[0][i] = aoC[0][i]; aoN[1][i] = aoC[1][i]; }
    const unsigned ldsw = (unsigned)wid * 1024u;
    const int aoff = lds_byte(wr * 64 + fr, fq * 8), boff = lds_byte(wc * 32 + fr, fq * 8);
#define PG8_SA(b, h) (((b) * 2 + (h)) * HTB)
#define PG8_SB(b, h) ((4 + (b) * 2 + (h)) * HTB)
#define PG8_STAGE(bufoff, gbase, voff) do { _Pragma("unroll") for (int _i = 0; _i < 2; ++_i) \
        __builtin_amdgcn_global_load_lds((const unsigned*)((const char*)(gbase) + (voff)[_i]), (LAS unsigned*)(lds + (bufoff) + ldsw + _i * 8192), 16, 0, 0); } while (0)
#define PG8_LDA(dst, b, h) do { _Pragma("unroll") for (int m = 0; m < 4; ++m) _Pragma("unroll") for (int k = 0; k < 2; ++k) dst[m][k] = *(const LAS bf16x8*)(lds + PG8_SA(b, h) + aoff + m * 2048 + k * 1024); } while (0)
#define PG8_LDB(dst, b, h) do { _Pragma("unroll") for (int n = 0; n < 2; ++n) _Pragma("unroll") for (int k = 0; k < 2; ++k) dst[n][k] = *(const LAS bf16x8*)(lds + PG8_SB(b, h) + boff + n * 2048 + k * 1024); } while (0)
#define PG8_MMA(ai, bj, At, Bt) do { __builtin_amdgcn_s_setprio(1); _Pragma("unroll") for (int m = 0; m < 4; ++m) _Pragma("unroll") for (int n = 0; n < 2; ++n) _Pragma("unroll") for (int k = 0; k < 2; ++k) \
        acc[ai][bj][m][n] = __builtin_amdgcn_mfma_f32_16x16x32_bf16(Bt[n][k], At[m][k], acc[ai][bj][m][n], 0, 0, 0); __builtin_amdgcn_s_setprio(0); } while (0)
#define PG8_WAIT_V(n) asm volatile("s_waitcnt vmcnt(" #n ")" ::: "memory")
#define PG8_WAIT_L(n) asm volatile("s_waitcnt lgkmcnt(" #n ")" ::: "memory")
#define PG8_BAR __builtin_amdgcn_s_barrier()
#define PG8_SCHED __builtin_amdgcn_sched_barrier(0)
    Unit cur, nxt; int ui = 0;
    if (!S.next(0, cur)) return;
    f32x4 acc[2][2][4][2];
#pragma unroll
    for (int a = 0; a < 2; ++a)
#pragma unroll
        for (int b = 0; b < 2; ++b)
#pragma unroll
            for (int m = 0; m < 4; ++m)
#pragma unroll
                for (int n = 0; n < 2; ++n) acc[a][b][m][n] = (f32x4){0.f, 0.f, 0.f, 0.f};
    bf16x8 At[4][2], B0[2][2], B1[2][2];
    const char* cA = S.a_base(cur); const char* cB = S.b_base(cur);
    if constexpr (GATHER) S.rows(cur, Rl, Cb, aoC);
    PG8_STAGE(PG8_SB(0, 0), cB, voffB); PG8_STAGE(PG8_SB(0, 1), cB + hstep, voffB); PG8_STAGE(PG8_SA(0, 0), cA, aoC[0]); PG8_STAGE(PG8_SA(0, 1), cA, aoC[1]);
    if (wr == 1) PG8_BAR;
    PG8_WAIT_V(2); PG8_BAR;
    PG8_STAGE(PG8_SB(1, 0), cB + kstep, voffB); PG8_STAGE(PG8_SA(1, 0), cA + kstep, aoC[0]); PG8_STAGE(PG8_SB(1, 1), cB + hstep + kstep, voffB);
    PG8_WAIT_V(6); PG8_BAR;
    for (;;) {
        const bool has_next = S.next(ui + 1, nxt);
        const char* nA = has_next ? S.a_base(nxt) : cA; const char* nB = has_next ? S.b_base(nxt) : cB;
        if constexpr (GATHER) { if (has_next) S.rows(nxt, Rl, Cb, aoN); else { aoN[0][0] = aoC[0][0]; aoN[0][1] = aoC[0][1]; aoN[1][0] = aoC[1][0]; aoN[1][1] = aoC[1][1]; } }
        for (int t = 0; t < nt; t += 2) {
            const bool last = (t == nt - 2);
            const char* a1 = cA + (size_t)(t + 1) * kstep;
            const char* a2 = last ? nA : cA + (size_t)(t + 2) * kstep; const char* b2 = last ? nB : cB + (size_t)(t + 2) * kstep;
            const char* a3 = a2 + kstep; const char* b3 = b2 + kstep;
            unsigned o2[2][2];
            if constexpr (GATHER) { o2[0][0] = last ? aoN[0][0] : aoC[0][0]; o2[0][1] = last ? aoN[0][1] : aoC[0][1]; o2[1][0] = last ? aoN[1][0] : aoC[1][0]; o2[1][1] = last ? aoN[1][1] : aoC[1][1]; }
            else { o2[0][0] = aoC[0][0]; o2[0][1] = aoC[0][1]; o2[1][0] = aoC[1][0]; o2[1][1] = aoC[1][1]; }
            PG8_LDB(B0, 0, 0); PG8_LDB(B1, 0, 1); PG8_SCHED; PG8_LDA(At, 0, 0); PG8_STAGE(PG8_SA(1, 1), a1, aoC[1]);
            PG8_WAIT_V(8); PG8_WAIT_L(0); PG8_BAR; PG8_MMA(0, 0, At, B0); PG8_MMA(0, 1, At, B1); PG8_BAR; PG8_SCHED;
            PG8_LDA(At, 0, 1); PG8_STAGE(PG8_SB(0, 0), b2, voffB); PG8_STAGE(PG8_SB(0, 1), b2 + hstep, voffB); PG8_STAGE(PG8_SA(0, 0), a2, o2[0]);
            PG8_WAIT_V(8); PG8_WAIT_L(0); PG8_BAR; PG8_MMA(1, 0, At, B0); PG8_MMA(1, 1, At, B1); PG8_BAR; PG8_SCHED;
            PG8_LDB(B0, 1, 0); PG8_LDB(B1, 1, 1); PG8_SCHED; PG8_LDA(At, 1, 0); PG8_STAGE(PG8_SA(0, 1), a2, o2[1]);
            PG8_WAIT_V(8); PG8_WAIT_L(0); PG8_BAR; PG8_MMA(0, 0, At, B0); PG8_MMA(0, 1, At, B1); PG8_BAR; PG8_SCHED;
            PG8_LDA(At, 1, 1); PG8_STAGE(PG8_SB(1, 0), b3, voffB); PG8_STAGE(PG8_SB(1, 1), b3 + hstep, voffB); PG8_STAGE(PG8_SA(1, 0), a3, o2[0]);
            PG8_WAIT_V(8); PG8_WAIT_L(0); PG8_BAR; PG8_MMA(1, 0, At, B0); PG8_MMA(1, 1, At, B1); PG8_BAR; PG8_SCHED;
        }
        if (wr == 0) PG8_BAR;
        E(acc, cur, wr, wc, fr, fq);
        if (!has_next) break;
        if (!E.keep(cur)) {
#pragma unroll
            for (int a = 0; a < 2; ++a)
#pragma unroll
                for (int b = 0; b < 2; ++b)
#pragma unroll
                    for (int m = 0; m < 4; ++m)
#pragma unroll
                        for (int n = 0; n < 2; ++n) acc[a][b][m][n] = (f32x4){0.f, 0.f, 0.f, 0.f};
        }
        cur = nxt; cA = nA; cB = nB; ++ui;
        if constexpr (GATHER) { aoC[0][0] = aoN[0][0]; aoC[0][1] = aoN[0][1]; aoC[1][0] = aoN[1][0]; aoC[1][1] = aoN[1][1]; }
        if (wr == 1) PG8_BAR;
    }
    PG8_WAIT_V(0);
    PG8_BAR;
#undef PG8_SA
#undef PG8_SB
#undef PG8_STAGE
#undef PG8_LDA
#undef PG8_LDB
#undef PG8_MMA
#undef PG8_WAIT_V
#undef PG8_WAIT_L
#undef PG8_BAR
#undef PG8_SCHED
}
}
using pg8::Unit;

struct Frame {
    LAS unsigned char* lds;
    volatile LAS unsigned* MISC;
    gu32* ctl;
    int tid, lane, wave, vcu, G;
    unsigned char* ws; unsigned char* outb;
    const float* in[18];
};

__device__ __forceinline__ float wave_sum(float v) {
#pragma unroll
    for (int o = 1; o < 64; o <<= 1) v += __shfl_xor(v, o);
    return v;
}

__device__ __forceinline__ void tr_item(const float* W, int ldw, int k0, int n0, bf16* WT, int Kd, int drow0, const float* gain, LAS float* scr, int lane) {
#pragma unroll 8
    for (int i = 0; i < 32; ++i) { const int kk = 2 * i + (lane >> 5); float v = W[(size_t)(k0 + kk) * ldw + n0 + (lane & 31)]; if (gain) v *= gain[k0 + kk]; scr[kk * 33 + (lane & 31)] = v; }
    LDS_WAIT(); asm volatile("" ::: "memory");
    const int c = lane & 7;
#pragma unroll
    for (int j = 0; j < 4; ++j) { const int n = (lane >> 3) + 8 * j; const LAS float* s = scr + (8 * c) * 33 + n;
        u32x4 o; o.x = pk2(s[0 * 33], s[1 * 33]); o.y = pk2(s[2 * 33], s[3 * 33]); o.z = pk2(s[4 * 33], s[5 * 33]); o.w = pk2(s[6 * 33], s[7 * 33]);
        *(GAS u32x4*)(WT + (size_t)(drow0 + n) * Kd + k0 + 8 * c) = o; }
    LDS_WAIT(); asm volatile("" ::: "memory");
}

__device__ __forceinline__ void p0_prologue(Frame& F) {
    LAS float* scr = (LAS float*)(F.lds + F.wave * 16384);
    const int gw = F.vcu * NWAVES + F.wave, NGW = F.G * NWAVES;
    const float* w_in = F.in[2]; const float* w_a = F.in[5]; const float* w_b = F.in[7]; const float* w_o = F.in[8];
    const float* w_gate = F.in[14]; const float* w_up = F.in[15]; const float* w_down = F.in[16]; const float* g_ffn = F.in[9];
    bf16* WIN = (bf16*)(F.ws + WS_WIN); bf16* WA = (bf16*)(F.ws + WS_WA); bf16* WB = (bf16*)(F.ws + WS_WB); bf16* WO = (bf16*)(F.ws + WS_WO);
    bf16* WGU = (bf16*)(F.ws + WS_WGU); bf16* WD = (bf16*)(F.ws + WS_WD);
    constexpr int I_IN = 16 * 208, I_SQ = 16 * 32, I_G = 32 * 16 * 16, I_D = 32 * 8 * 32;
    constexpr int NITEMS = I_IN + 3 * I_SQ + 2 * I_G + I_D;
    for (int it = gw; it < NITEMS; it += NGW) {
        int r = it;
        if (r < I_IN) { const int kb = r / 208, nb = r % 208, n0 = 32 * nb; int dr = n0;
            if (n0 >= 1024 && n0 < 2048) { const int ch = n0 - 1024; dr = 1024 + 256 * (ch >> 7) + (ch & 127); }
            else if (n0 >= 2048 && n0 < 3072) { const int ch = n0 - 2048; dr = 1024 + 256 * (ch >> 7) + 128 + (ch & 127); }
            tr_item(w_in, NCOL, 64 * kb, n0, WIN, D, dr, nullptr, scr, F.lane); continue; } r -= I_IN;
        if (r < I_SQ) { tr_item(w_a, D, 64 * (r / 32), 32 * (r % 32), WA, D, 32 * (r % 32), nullptr, scr, F.lane); continue; } r -= I_SQ;
        if (r < I_SQ) { tr_item(w_b, D, 64 * (r / 32), 32 * (r % 32), WB, D, 32 * (r % 32), nullptr, scr, F.lane); continue; } r -= I_SQ;
        if (r < I_SQ) { tr_item(w_o, D, 64 * (r / 32), 32 * (r % 32), WO, D, 32 * (r % 32), nullptr, scr, F.lane); continue; } r -= I_SQ;
        if (r < I_G) { const int e = r / 256, q = r % 256, kb = q / 16, nb = q % 16, f0 = 32 * nb;
            tr_item(w_gate + (size_t)e * D * FF, FF, 64 * kb, f0, WGU + (size_t)e * D * D, D, 256 * (f0 >> 7) + (f0 & 127), g_ffn, scr, F.lane); continue; } r -= I_G;
        if (r < I_G) { const int e = r / 256, q = r % 256, kb = q / 16, nb = q % 16, f0 = 32 * nb;
            tr_item(w_up + (size_t)e * D * FF, FF, 64 * kb, f0, WGU + (size_t)e * D * D, D, 256 * (f0 >> 7) + 128 + (f0 & 127), g_ffn, scr, F.lane); continue; } r -= I_G;
        { const int e = r / 256, q = r % 256, kb = q / 32, nb = q % 32;
            tr_item(w_down + (size_t)e * FF * D, D, 64 * kb, 32 * nb, WD + (size_t)e * D * FF, FF, 32 * nb, nullptr, scr, F.lane); }
    }
    { const float* x = F.in[0]; const float* g = F.in[1]; bf16* H = (bf16*)(F.ws + WS_H);
      f32x4 gv[4];
#pragma unroll
      for (int j = 0; j < 4; ++j) gv[j] = *((const GAS f32x4*)g + F.lane + 64 * j);
      for (int m = gw; m < M; m += NGW) {
        const GAS f32x4* xr = (const GAS f32x4*)(x + (size_t)m * D) + F.lane;
        f32x4 v[4]; float s = 0.f;
#pragma unroll
        for (int j = 0; j < 4; ++j) { v[j] = xr[64 * j]; s += (v[j].x * v[j].x + v[j].y * v[j].y) + (v[j].z * v[j].z + v[j].w * v[j].w); }
        const float rs = 1.0f / sqrtf(wave_sum(s) * (1.f / D) + EPS);
        GAS u32x2* o8 = (GAS u32x2*)(H + (size_t)m * D) + F.lane;
#pragma unroll
        for (int j = 0; j < 4; ++j) { u32x2 w; w.x = pk2(v[j].x * rs * gv[j].x, v[j].y * rs * gv[j].y); w.y = pk2(v[j].z * rs * gv[j].z, v[j].w * rs * gv[j].w); o8[64 * j] = w; }
      } }
    { const float* wg = F.in[10]; const float* we = F.in[12]; u32x4* RWF = (u32x4*)(F.ws + WS_RWF);
      const int gt = F.vcu * (NWAVES * 64) + F.tid, NGT = F.G * NWAVES * 64;
      for (int idx = gt; idx < 32 * 3 * 64; idx += NGT) {
        const int l = idx & 63, st = idx >> 6, t = st % 3, s = st / 3, col = 16 * t + (l & 15), k0 = 32 * s + 8 * (l >> 4);
        unsigned hi[8], lo[8];
#pragma unroll
        for (int j = 0; j < 8; ++j) { const int k = k0 + j; float w = 0.f;
            if (col < 4) w = wg[k * 4 + col]; else if (col < 36) w = we[k * 32 + col - 4];
            w *= g_ffn[k]; const unsigned h = f2bf(w); hi[j] = h; lo[j] = f2bf(w - bf2f((unsigned short)h)); }
        u32x4 vh, vl; vh.x = hi[0] | (hi[1] << 16); vh.y = hi[2] | (hi[3] << 16); vh.z = hi[4] | (hi[5] << 16); vh.w = hi[6] | (hi[7] << 16);
        vl.x = lo[0] | (lo[1] << 16); vl.y = lo[2] | (lo[3] << 16); vl.z = lo[4] | (lo[5] << 16); vl.w = lo[6] | (lo[7] << 16);
        RWF[((size_t)st * 2 + 0) * 64 + l] = vh; RWF[((size_t)st * 2 + 1) * 64 + l] = vl; } }
}

constexpr size_t TSTEP1024 = (size_t)256 * 1024 * 2;
struct SchedPlain {
    const char* A; const char* Bt; int nM, nN, G, c; size_t tstep;
    __device__ __forceinline__ bool next(int i, Unit& u) const { u.x0 = 0; u.x1 = 0; u.x2 = 0; return pg8::static_unit((long)i * G + c, nM, nN, u.pm, u.pn); }
    __device__ __forceinline__ const char* a_base(const Unit& u) const { return A + (size_t)u.pm * tstep; }
    __device__ __forceinline__ const char* b_base(const Unit& u) const { return Bt + (size_t)u.pn * tstep; }
    __device__ __forceinline__ void rows(const Unit&, const int*, const int*, unsigned (&)[2][2]) const {}
};
struct SchedDual {
    const char* A0; long dA; const char* B0; long dB; int nM, nN, G, c;
    __device__ __forceinline__ bool next(int i, Unit& u) const { u.x0 = i & 1; u.x1 = 0; u.x2 = 0; return pg8::static_unit((long)(i >> 1) * G + c, nM, nN, u.pm, u.pn); }
    __device__ __forceinline__ const char* a_base(const Unit& u) const { return A0 + ((-(long)u.x0) & dA) + (size_t)u.pm * TSTEP1024; }
    __device__ __forceinline__ const char* b_base(const Unit& u) const { return B0 + ((-(long)u.x0) & dB) + (size_t)u.pn * TSTEP1024; }
    __device__ __forceinline__ void rows(const Unit&, const int*, const int*, unsigned (&)[2][2]) const {}
};
struct SchedMoE {
    const char* A; const char* Bt; const LAS int* pfx; const int* ltok; int G, c; int K; size_t a_tstep, b_estep, b_tstep; bool gather;
    __device__ __forceinline__ bool next(int i, Unit& u) const {
        const int nM = pfx[32];
        if (!pg8::static_unit((long)i * G + c, nM, 4, u.pm, u.pn)) return false;
        int e = 0;
#pragma unroll 1
        for (int j = 1; j < NEXP; ++j) if (pfx[j] <= u.pm) e = j;
        e = __builtin_amdgcn_readfirstlane(e);
        const int mt = u.pm - pfx[e];
        u.x0 = e; u.x1 = pfx[40 + e] - 256 * mt; u.x2 = e * CAP + 256 * mt; return true;
    }
    __device__ __forceinline__ const char* a_base(const Unit& u) const { return gather ? A : A + (size_t)u.pm * a_tstep; }
    __device__ __forceinline__ const char* b_base(const Unit& u) const { return Bt + (size_t)u.x0 * b_estep + (size_t)u.pn * b_tstep; }
    __device__ __forceinline__ void rows(const Unit& u, const int* Rl, const int* Cb, unsigned (&off)[2][2]) const {
#pragma unroll
        for (int h = 0; h < 2; ++h)
#pragma unroll
            for (int i = 0; i < 2; ++i) { const int rl = h * 128 + Rl[i]; int tok = 0; if (rl < u.x1) tok = ltok[u.x2 + rl] >> 1; off[h][i] = (unsigned)tok * (unsigned)(K * 2) + (unsigned)Cb[i]; }
    }
};

struct EpiG1 {
    bf16 *Bo, *CUo, *Qo, *Ko, *Vo, *GAo, *GBo;
    __device__ __forceinline__ bool keep(const Unit&) const { return false; }
    __device__ __forceinline__ void operator()(f32x4 (&acc)[2][2][4][2], const Unit& u, int wr, int wc, int fr, int fq) const {
        const int row0 = u.pm * 256 + wr * 64 + fr, pn = u.pn, cb = wc * 32 + 8 * fq;
        if (pn >= 4 && pn < 12) {
#pragma unroll
            for (int ai = 0; ai < 2; ++ai)
#pragma unroll
                for (int m = 0; m < 4; ++m) { bf16* rowp = CUo + (size_t)(row0 + ai * 128 + m * 16) * D + 128 * (pn - 4) + cb;
                    const f32x4 v0 = acc[ai][0][m][0] * acc[ai][1][m][0], v1 = acc[ai][0][m][1] * acc[ai][1][m][1];
                    u32x4 w; w.x = cvt_pk_bf16(v0[0], v0[1]); w.y = cvt_pk_bf16(v0[2], v0[3]); w.z = cvt_pk_bf16(v1[0], v1[1]); w.w = cvt_pk_bf16(v1[2], v1[3]);
                    *(u32x4*)rowp = w; }
            return;
        }
        bf16* base; int ldc = D, col = cb; int mode = 0; float sc = 1.f;
        if (pn < 4) { base = Bo; col += 256 * pn; }
        else if (pn < 16) { base = Qo; col += 256 * (pn - 12); sc = QSCALE; }
        else if (pn == 16) { base = Ko; ldc = KVW; }
        else if (pn == 17) { base = Vo; ldc = KVW; }
        else if (pn < 22) { base = GAo; col += 256 * (pn - 18); mode = 1; }
        else { base = GBo; col += 256 * (pn - 22); mode = 1; }
#pragma unroll
        for (int ai = 0; ai < 2; ++ai)
#pragma unroll
            for (int m = 0; m < 4; ++m) { bf16* rowp = base + (size_t)(row0 + ai * 128 + m * 16) * ldc + col;
#pragma unroll
                for (int bj = 0; bj < 2; ++bj) { f32x4 v0 = acc[ai][bj][m][0], v1 = acc[ai][bj][m][1];
                    if (mode == 1) {
#pragma unroll
                        for (int q = 0; q < 4; ++q) { v0[q] = fast_sigmoid(v0[q]); v1[q] = fast_sigmoid(v1[q]); } }
                    else { v0 = v0 * sc; v1 = v1 * sc; }
                    u32x4 w; w.x = cvt_pk_bf16(v0[0], v0[1]); w.y = cvt_pk_bf16(v0[2], v0[3]); w.z = cvt_pk_bf16(v1[0], v1[1]); w.w = cvt_pk_bf16(v1[2], v1[3]);
                    *(u32x4*)(rowp + bj * 128) = w; } }
    }
};
struct EpiG3 {
    const bf16* GA; const bf16* GB; bf16* MO;
    __device__ __forceinline__ bool keep(const Unit& u) const { return u.x0 == 0; }
    __device__ __forceinline__ void operator()(f32x4 (&acc)[2][2][4][2], const Unit& u, int wr, int wc, int fr, int fq) const {
        const int row0 = u.pm * 256 + wr * 64 + fr, col0 = u.pn * 256 + wc * 32 + 8 * fq; const bool s0 = (u.x0 == 0);
#pragma unroll
        for (int ai = 0; ai < 2; ++ai)
#pragma unroll
            for (int m = 0; m < 4; ++m) { const size_t off = (size_t)(row0 + ai * 128 + m * 16) * D + col0;
#pragma unroll
                for (int bj = 0; bj < 2; ++bj) {
                    const u32x4 gb = *(const u32x4*)(GB + off + bj * 128);
                    float b[8] = {bflo(gb.x), bfhi(gb.x), bflo(gb.y), bfhi(gb.y), bflo(gb.z), bfhi(gb.z), bflo(gb.w), bfhi(gb.w)};
#pragma unroll
                    for (int q = 0; q < 8; ++q) b[q] = fmaxf(b[q], 1e-30f);
                    if (s0) { const u32x4 ga = *(const u32x4*)(GA + off + bj * 128);
                        const float a[8] = {bflo(ga.x), bfhi(ga.x), bflo(ga.y), bfhi(ga.y), bflo(ga.z), bfhi(ga.z), bflo(ga.w), bfhi(ga.w)};
#pragma unroll
                        for (int q = 0; q < 4; ++q) { acc[ai][bj][m][0][q] *= a[q] * __builtin_amdgcn_rcpf(b[q]); acc[ai][bj][m][1][q] *= a[4 + q] * __builtin_amdgcn_rcpf(b[4 + q]); }
                    } else {
                        f32x4 v0 = acc[ai][bj][m][0], v1 = acc[ai][bj][m][1];
#pragma unroll
                        for (int q = 0; q < 4; ++q) { v0[q] *= b[q]; v1[q] *= b[4 + q]; }
                        u32x4 w; w.x = cvt_pk_bf16(v0[0], v0[1]); w.y = cvt_pk_bf16(v0[2], v0[3]); w.z = cvt_pk_bf16(v1[0], v1[1]); w.w = cvt_pk_bf16(v1[2], v1[3]);
                        *(u32x4*)(MO + off + bj * 128) = w; } } }
    }
};
struct EpiG4 {
    const float* X; float* X1; bf16* X1B;
    __device__ __forceinline__ bool keep(const Unit&) const { return false; }
    __device__ __forceinline__ void operator()(f32x4 (&acc)[2][2][4][2], const Unit& u, int wr, int wc, int fr, int fq) const {
        const int row0 = u.pm * 256 + wr * 64 + fr, col0 = u.pn * 256 + wc * 32 + 8 * fq;
#pragma unroll
        for (int ai = 0; ai < 2; ++ai)
#pragma unroll
            for (int m = 0; m < 4; ++m) { const size_t off = (size_t)(row0 + ai * 128 + m * 16) * D + col0;
#pragma unroll
                for (int bj = 0; bj < 2; ++bj) {
                    const f32x4 x0 = *(const f32x4*)(X + off + bj * 128), x1 = *(const f32x4*)(X + off + bj * 128 + 4);
                    const f32x4 v0 = acc[ai][bj][m][0] + x0, v1 = acc[ai][bj][m][1] + x1;
                    *(f32x4*)(X1 + off + bj * 128) = v0; *(f32x4*)(X1 + off + bj * 128 + 4) = v1;
                    u32x4 w; w.x = cvt_pk_bf16(v0[0], v0[1]); w.y = cvt_pk_bf16(v0[2], v0[3]); w.z = cvt_pk_bf16(v1[0], v1[1]); w.w = cvt_pk_bf16(v1[2], v1[3]);
                    *(u32x4*)(X1B + off + bj * 128) = w; }
                if (m & 1) asm volatile("" ::: "memory"); }
    }
};
struct EpiG6 {
    const float* LR; const float* LW; bf16* ACT;
    __device__ __forceinline__ bool keep(const Unit&) const { return false; }
    __device__ __forceinline__ void operator()(f32x4 (&acc)[2][2][4][2], const Unit& u, int wr, int wc, int fr, int fq) const {
        const int rl0 = wr * 64 + fr, col0 = u.pn * 128 + wc * 32 + 8 * fq;
#pragma unroll
        for (int ai = 0; ai < 2; ++ai)
#pragma unroll
            for (int m = 0; m < 4; ++m) { const int rl = rl0 + ai * 128 + m * 16; float rs = 0.f, wsv = 0.f;
                if (rl < u.x1) { rs = LR[u.x2 + rl]; wsv = LW[u.x2 + rl]; }
                float o[8];
#pragma unroll
                for (int n = 0; n < 2; ++n)
#pragma unroll
                    for (int q = 0; q < 4; ++q) { const float g = acc[ai][0][m][n][q] * rs, up = acc[ai][1][m][n][q] * rs; o[4 * n + q] = wsv * g * fast_sigmoid(g) * up; }
                u32x4 w; w.x = cvt_pk_bf16(o[0], o[1]); w.y = cvt_pk_bf16(o[2], o[3]); w.z = cvt_pk_bf16(o[4], o[5]); w.w = cvt_pk_bf16(o[6], o[7]);
                *(u32x4*)(ACT + (size_t)(u.pm * 256 + rl) * FF + col0) = w; }
    }
};
struct EpiG7 {
    const int* LT; bf16* PAIRS;
    __device__ __forceinline__ bool keep(const Unit&) const { return false; }
    __device__ __forceinline__ void operator()(f32x4 (&acc)[2][2][4][2], const Unit& u, int wr, int wc, int fr, int fq) const {
        const int rl0 = wr * 64 + fr, col0 = u.pn * 256 + wc * 32 + 8 * fq;
#pragma unroll
        for (int ai = 0; ai < 2; ++ai)
#pragma unroll
            for (int m = 0; m < 4; ++m) { const int rl = rl0 + ai * 128 + m * 16;
                if (rl < u.x1) { const int pid = LT[u.x2 + rl]; bf16* rowp = PAIRS + (size_t)pid * D + col0;
#pragma unroll
                    for (int bj = 0; bj < 2; ++bj) { const f32x4 v0 = acc[ai][bj][m][0], v1 = acc[ai][bj][m][1];
                        u32x4 w; w.x = cvt_pk_bf16(v0[0], v0[1]); w.y = cvt_pk_bf16(v0[2], v0[3]); w.z = cvt_pk_bf16(v1[0], v1[1]); w.w = cvt_pk_bf16(v1[2], v1[3]);
                        *(u32x4*)(rowp + bj * 128) = w; } } }
    }
};

constexpr int KP = 144;
constexpr int ATT_K_OFF = 0, ATT_V_OFF = 256 * KP;
__device__ __forceinline__ s16x4 vtr(const LAS unsigned char* p) { return __builtin_bit_cast(s16x4, __builtin_amdgcn_ds_read_tr16_b64_v4i16((LAS s16x4*)p)); }

__device__ __forceinline__ void attn_phase(Frame& F, bf16* QO, const bf16* Kg, const bf16* Vg, const float* sinks) {
    LAS unsigned char* Kl = F.lds + ATT_K_OFF; LAS unsigned char* Vl = F.lds + ATT_V_OFF;
    const int tid = F.tid, lane = F.lane, wid = F.wave, r32 = lane & 31, hi = lane >> 5;
    for (int u = F.vcu; u < BATCH * (SEQ / 128) * NKV; u += F.G) {
        const int kh = u & 3, n = (u >> 2) & 63, b = u >> 8;
        const int T0 = b * SEQ + n * 128;
        u32x4 kv[4], vv[4];
#pragma unroll
        for (int i = 0; i < 4; ++i) { const int piece = tid + 512 * i, row = piece >> 3, c = piece & 7; const bool ok = (n > 0) || (row >= 128);
            const long tok = (long)T0 - 128 + row;
            kv[i] = (u32x4){0u, 0u, 0u, 0u}; vv[i] = (u32x4){0u, 0u, 0u, 0u};
            if (ok) { kv[i] = *(const u32x4*)(Kg + tok * KVW + kh * 64 + c * 8); vv[i] = *(const u32x4*)(Vg + tok * KVW + kh * 64 + c * 8); } }
#pragma unroll
        for (int i = 0; i < 4; ++i) { const int piece = tid + 512 * i, row = piece >> 3, c = piece & 7;
            *(LAS u32x4*)(Kl + row * KP + c * 16) = kv[i];
            *(LAS u32x4*)(Vl + row * 128 + ((c * 16) ^ (((row >> 1) & 1) << 6))) = vv[i]; }
        __syncthreads();
        const int g = wid >> 1, head = kh * 4 + g;
        const float slope2 = __builtin_amdgcn_exp2f(-0.5f * (float)(head + 1)) * LOG2E;
        const float sink2 = sinks[head] * LOG2E;
#pragma unroll 1
        for (int p = 0; p < 2; ++p) {
            const int qs = 2 * (wid & 1) + p;
            const long qrow = (long)T0 + 32 * qs + r32;
            bf16* qp = QO + qrow * D + head * 64;
            bf16x8 qf[4];
#pragma unroll
            for (int ks = 0; ks < 4; ++ks) qf[ks] = *(const bf16x8*)(qp + 16 * ks + 8 * hi);
            f32x16 s[5];
#pragma unroll
            for (int ti = 0; ti < 5; ++ti) { const LAS unsigned char* kb = Kl + (32 * (qs + ti) + r32) * KP + 16 * hi;
                f32x16 a = {};
#pragma unroll
                for (int ks = 0; ks < 4; ++ks) { const bf16x8 kf = *(const LAS bf16x8*)(kb + 32 * ks); a = __builtin_amdgcn_mfma_f32_32x32x16_bf16(kf, qf[ks], a, 0, 0, 0); }
                s[ti] = a; }
            const float base = slope2 * (float)(4 * hi - r32 - 128);
            float mx = -INFINITY;
#pragma unroll
            for (int ti = 0; ti < 5; ++ti) { const bool dead = (n == 0) && (qs + ti < 4);
#pragma unroll
                for (int r = 0; r < 16; ++r) { const int ro = (r & 3) + 8 * (r >> 2); float v = s[ti][r] + (slope2 * (float)(32 * ti + ro) + base);
                    const int rel0 = ro + 4 * hi - r32;
                    bool ok = !dead;
                    if (ti == 0) ok = ok && (rel0 >= 1);
                    if (ti == 4) ok = ok && (rel0 <= 0);
                    v = ok ? v : -INFINITY; s[ti][r] = v; mx = fmaxf(mx, v); } }
            mx = fmaxf(mx, __shfl_xor(mx, 32)); mx = fmaxf(mx, sink2);
            float sum = 0.f;
#pragma unroll
            for (int ti = 0; ti < 5; ++ti)
#pragma unroll
                for (int r = 0; r < 16; ++r) { const float e = __builtin_amdgcn_exp2f(s[ti][r] - mx); s[ti][r] = e; sum += e; }
            sum += __shfl_xor(sum, 32);
            const float inv = 1.0f / (sum + __builtin_amdgcn_exp2f(sink2 - mx));
            f32x16 o[2]; o[0] = (f32x16){}; o[1] = (f32x16){};
            const int i16 = lane & 15, gsel = (lane >> 4) & 1;
            const int vcol = (gsel * 16 + 4 * (i16 & 3)) * 2;
            const int vswz = ((i16 >> 3) & 1) << 6;
#pragma unroll
            for (int ti = 0; ti < 5; ++ti)
#pragma unroll
                for (int s2 = 0; s2 < 2; ++s2) {
                    u32x4 pw; pw.x = cvt_pk_bf16(s[ti][8 * s2 + 0], s[ti][8 * s2 + 1]); pw.y = cvt_pk_bf16(s[ti][8 * s2 + 2], s[ti][8 * s2 + 3]);
                    pw.z = cvt_pk_bf16(s[ti][8 * s2 + 4], s[ti][8 * s2 + 5]); pw.w = cvt_pk_bf16(s[ti][8 * s2 + 6], s[ti][8 * s2 + 7]);
                    const bf16x8 pf = __builtin_bit_cast(bf16x8, pw);
                    const int key0 = 32 * (qs + ti) + 16 * s2 + 4 * hi + (i16 >> 2);
#pragma unroll
                    for (int dt = 0; dt < 2; ++dt) {
                        const LAS unsigned char* vp = Vl + key0 * 128 + ((dt * 64 + vcol) ^ vswz);
                        const s16x4 lo = vtr(vp), hh = vtr(vp + 8 * 128);
                        const bf16x8 vf = (bf16x8){lo[0], lo[1], lo[2], lo[3], hh[0], hh[1], hh[2], hh[3]};
                        o[dt] = __builtin_amdgcn_mfma_f32_32x32x16_bf16(vf, pf, o[dt], 0, 0, 0); } }
#pragma unroll
            for (int dt = 0; dt < 2; ++dt)
#pragma unroll
                for (int rq = 0; rq < 4; ++rq) { u32x2 w; w.x = cvt_pk_bf16(o[dt][4 * rq] * inv, o[dt][4 * rq + 1] * inv); w.y = cvt_pk_bf16(o[dt][4 * rq + 2] * inv, o[dt][4 * rq + 3] * inv);
                    *(u32x2*)(qp + 32 * dt + 8 * rq + 4 * hi) = w; }
        }
        __syncthreads();
    }
}

__device__ __forceinline__ void conv_phase(Frame& F, const bf16* Bg, const bf16* CUg, bf16* YC, const float* cw, const float* cbias) {
    const int gw = F.vcu * NWAVES + F.wave, NGW = F.G * NWAVES;
    for (int it = gw; it < (M / 32) * 2; it += NGW) {
        const int half = it & 1, t0 = (it >> 1) * 32, c0 = half * 512 + F.lane * 8;
        float w0[8], w1[8], w2[8], cb[8], p1[8], p2[8];
#pragma unroll
        for (int q = 0; q < 8; ++q) { w0[q] = cw[c0 + q]; w1[q] = cw[D + c0 + q]; w2[q] = cw[2 * D + c0 + q]; cb[q] = cbias[c0 + q]; p1[q] = 0.f; p2[q] = 0.f; }
        if ((t0 & (SEQ - 1)) != 0) {
            const u32x4 a = *(const u32x4*)(CUg + (size_t)(t0 - 1) * D + c0), c = *(const u32x4*)(CUg + (size_t)(t0 - 2) * D + c0);
            p1[0] = bflo(a.x); p1[1] = bfhi(a.x); p1[2] = bflo(a.y); p1[3] = bfhi(a.y); p1[4] = bflo(a.z); p1[5] = bfhi(a.z); p1[6] = bflo(a.w); p1[7] = bfhi(a.w);
            p2[0] = bflo(c.x); p2[1] = bfhi(c.x); p2[2] = bflo(c.y); p2[3] = bfhi(c.y); p2[4] = bflo(c.z); p2[5] = bfhi(c.z); p2[6] = bflo(c.w); p2[7] = bfhi(c.w);
        }
#pragma unroll 4
        for (int t = 0; t < 32; ++t) {
            const u32x4 a = *(const u32x4*)(CUg + (size_t)(t0 + t) * D + c0), bb = *(const u32x4*)(Bg + (size_t)(t0 + t) * D + c0);
            const float cu[8] = {bflo(a.x), bfhi(a.x), bflo(a.y), bfhi(a.y), bflo(a.z), bfhi(a.z), bflo(a.w), bfhi(a.w)};
            const float bv[8] = {bflo(bb.x), bfhi(bb.x), bflo(bb.y), bfhi(bb.y), bflo(bb.z), bfhi(bb.z), bflo(bb.w), bfhi(bb.w)};
            float y[8];
#pragma unroll
            for (int q = 0; q < 8; ++q) { y[q] = bv[q] * (w0[q] * p2[q] + w1[q] * p1[q] + w2[q] * cu[q] + cb[q]); p2[q] = p1[q]; p1[q] = cu[q]; }
            u32x4 w; w.x = pk2(y[0], y[1]); w.y = pk2(y[2], y[3]); w.z = pk2(y[4], y[5]); w.w = pk2(y[6], y[7]);
            *(u32x4*)(YC + (size_t)(t0 + t) * D + c0) = w;
        }
    }
}

__device__ __forceinline__ void router_phase(Frame& F, const float* X1) {
    const int lane = F.lane, wid = F.wave, tid = F.tid;
    LAS float* lg = (LAS float*)(F.lds + wid * 3072);
    LAS int* lcnt = (LAS int*)(F.lds + 32768); LAS int* lbase = lcnt + 32;
    const u32x4* RWF = (const u32x4*)(F.ws + WS_RWF);
    const float* bg = F.in[11]; const float* be = F.in[13];
    int* LT = (int*)(F.ws + WS_LTOK); float* LR = (float*)(F.ws + WS_LR); float* LW = (float*)(F.ws + WS_LW);
    for (int tb = F.vcu; tb < M / 128; tb += F.G) {
        if (tid < 32) lcnt[tid] = 0;
        __syncthreads();
        const int tok0 = tb * 128 + wid * 16, row = lane & 15, kg = lane >> 4;
        const float* xr = X1 + (size_t)(tok0 + row) * D + 8 * kg;
        f32x4 acc[3]; acc[0] = (f32x4){0.f, 0.f, 0.f, 0.f}; acc[1] = acc[0]; acc[2] = acc[0];
        float ss = 0.f;
#pragma unroll 4
        for (int s = 0; s < 32; ++s) {
            const f32x4 a0 = *(const f32x4*)(xr + 32 * s), a1 = *(const f32x4*)(xr + 32 * s + 4);
            ss += (a0.x * a0.x + a0.y * a0.y) + (a0.z * a0.z + a0.w * a0.w) + (a1.x * a1.x + a1.y * a1.y) + (a1.z * a1.z + a1.w * a1.w);
            const float xv[8] = {a0.x, a0.y, a0.z, a0.w, a1.x, a1.y, a1.z, a1.w};
            unsigned h[8], l[8];
#pragma unroll
            for (int j = 0; j < 8; ++j) { h[j] = f2bf(xv[j]); l[j] = f2bf(xv[j] - bf2f((unsigned short)h[j])); }
            u32x4 ah, al; ah.x = h[0] | (h[1] << 16); ah.y = h[2] | (h[3] << 16); ah.z = h[4] | (h[5] << 16); ah.w = h[6] | (h[7] << 16);
            al.x = l[0] | (l[1] << 16); al.y = l[2] | (l[3] << 16); al.z = l[4] | (l[5] << 16); al.w = l[6] | (l[7] << 16);
            const bf16x8 Ah = __builtin_bit_cast(bf16x8, ah), Al = __builtin_bit_cast(bf16x8, al);
#pragma unroll
            for (int t = 0; t < 3; ++t) {
                const bf16x8 Bh = __builtin_bit_cast(bf16x8, RWF[((size_t)(s * 3 + t) * 2 + 0) * 64 + lane]);
                const bf16x8 Bl = __builtin_bit_cast(bf16x8, RWF[((size_t)(s * 3 + t) * 2 + 1) * 64 + lane]);
                acc[t] = __builtin_amdgcn_mfma_f32_16x16x32_bf16(Ah, Bh, acc[t], 0, 0, 0);
                acc[t] = __builtin_amdgcn_mfma_f32_16x16x32_bf16(Al, Bh, acc[t], 0, 0, 0);
                acc[t] = __builtin_amdgcn_mfma_f32_16x16x32_bf16(Ah, Bl, acc[t], 0, 0, 0);
            }
        }
#pragma unroll
        for (int t = 0; t < 3; ++t)
#pragma unroll
            for (int i = 0; i < 4; ++i) lg[(4 * kg + i) * 48 + 16 * t + row] = acc[t][i];
        ss += __shfl_xor(ss, 16); ss += __shfl_xor(ss, 32);
        const float rr = 1.0f / sqrtf(ss * (1.f / D) + EPS);
        LDS_WAIT(); asm volatile("" ::: "memory");
        int e0 = 0, e1 = 0, rank0 = 0, rank1 = 0; float w0 = 0.f, w1 = 0.f;
        if (lane < 16) {
            const LAS float* my = lg + lane * 48;
            float gl[4];
#pragma unroll
            for (int j = 0; j < 4; ++j) gl[j] = rr * my[j] + bg[j];
            int gi = 0; float gm = gl[0];
#pragma unroll
            for (int j = 1; j < 4; ++j) if (gl[j] > gm) { gm = gl[j]; gi = j; }
            float den = 0.f;
#pragma unroll
            for (int j = 0; j < 4; ++j) den += __expf(gl[j] - gm);
            const float pg = 1.0f / den;
            float v0 = -INFINITY, v1 = -INFINITY; int i0 = 0, i1 = 0;
#pragma unroll
            for (int i = 0; i < 8; ++i) { const float v = rr * my[4 + 8 * gi + i] + be[8 * gi + i];
                if (v > v0) { v1 = v0; i1 = i0; v0 = v; i0 = i; } else if (v > v1) { v1 = v; i1 = i; } }
            const float ex = __expf(v1 - v0), s0 = 1.0f / (1.0f + ex);
            w0 = pg * s0; w1 = pg * (ex * s0);
            e0 = 8 * gi + i0; e1 = 8 * gi + i1;
            rank0 = __hip_atomic_fetch_add(lcnt + e0, 1, __ATOMIC_RELAXED, __HIP_MEMORY_SCOPE_WORKGROUP); rank1 = __hip_atomic_fetch_add(lcnt + e1, 1, __ATOMIC_RELAXED, __HIP_MEMORY_SCOPE_WORKGROUP);
        }
        __syncthreads();
        if (tid < 32) { const int c = lcnt[tid]; int bs = 0; if (c > 0) bs = (int)__hip_atomic_fetch_add((unsigned*)(F.ctl + CW_CNT + tid), (unsigned)c, RLX_AGENT); lbase[tid] = bs; }
        __syncthreads();
        if (lane < 16) { const int tok = tok0 + lane;
            const int p0 = e0 * CAP + lbase[e0] + rank0, p1 = e1 * CAP + lbase[e1] + rank1;
            LT[p0] = tok * 2; LR[p0] = rr; LW[p0] = w0;
            LT[p1] = tok * 2 + 1; LR[p1] = rr; LW[p1] = w1; }
        __syncthreads();
    }
}

__device__ __forceinline__ void final_phase(Frame& F, float* X1, const bf16* PAIRS, const float* g) {
    const int gw = F.vcu * NWAVES + F.wave, NGW = F.G * NWAVES;
    f32x4 gv[4];
#pragma unroll
    for (int j = 0; j < 4; ++j) gv[j] = *((const GAS f32x4*)g + F.lane + 64 * j);
    for (int m = gw; m < M; m += NGW) {
        GAS f32x4* xr = (GAS f32x4*)(X1 + (size_t)m * D) + F.lane;
        const GAS u32x2* pa = (const GAS u32x2*)(PAIRS + (size_t)(2 * m) * D) + F.lane; const GAS u32x2* pb = (const GAS u32x2*)(PAIRS + (size_t)(2 * m + 1) * D) + F.lane;
        f32x4 v[4]; float s = 0.f;
#pragma unroll
        for (int j = 0; j < 4; ++j) { v[j] = xr[64 * j]; const u32x2 a = pa[64 * j], b = pb[64 * j];
            v[j].x += bflo(a.x) + bflo(b.x); v[j].y += bfhi(a.x) + bfhi(b.x); v[j].z += bflo(a.y) + bflo(b.y); v[j].w += bfhi(a.y) + bfhi(b.y);
            s += (v[j].x * v[j].x + v[j].y * v[j].y) + (v[j].z * v[j].z + v[j].w * v[j].w); }
        const float rs = 1.0f / sqrtf(wave_sum(s) * (1.f / D) + EPS);
#pragma unroll
        for (int j = 0; j < 4; ++j) xr[64 * j] = v[j] * rs * gv[j];
    }
}

struct Args { const float* in[18]; float* out; unsigned char* ws; int ph_lo, ph_hi; };
__global__ void __launch_bounds__(NWAVES * 64, 2) mk_fwd(Args args) {
    extern __shared__ __attribute__((aligned(16))) unsigned char lds[];
    Frame F;
    F.lds = (LAS unsigned char*)lds;
    F.MISC = (volatile LAS unsigned*)(F.lds + MISC_OFF);
    F.tid = threadIdx.x; F.lane = F.tid & 63; F.wave = __builtin_amdgcn_readfirstlane(F.tid >> 6);
    F.G = gridDim.x; { const int bx = blockIdx.x; F.vcu = (F.G % 8 == 0) ? (bx % 8) * (F.G / 8) + bx / 8 : bx; }
    F.ws = args.ws; F.outb = (unsigned char*)args.out; F.ctl = (gu32*)(args.ws + WS_CTL);
#pragma unroll
    for (int i = 0; i < 18; ++i) F.in[i] = args.in[i];
    for (int u = F.tid; u < (LDS_BYTES - LDSCTL_OFF) / 4; u += NWAVES * 64) ((LAS unsigned*)(F.lds + LDSCTL_OFF))[u] = 0u;
    __syncthreads();
    XcdBarrier bar; bar.bar = (unsigned*)(F.ctl + CW_BAR); bar.x = 0; bar.st = nullptr;
    if (N_LAUNCHES == 1) bar = xcd_barrier_post((unsigned*)(F.ctl + CW_BAR), F.MISC + 8);
    const int lo = args.ph_lo, hi = args.ph_hi;
#define IN(k) (lo <= (k) && (k) < hi)
#define BOTH(k) (IN(k) && IN((k) + 1))
#define GRID_BAR() xcd_barrier(bar)

    bf16* H = (bf16*)(F.ws + WS_H); bf16* Bb = (bf16*)(F.ws + WS_B); bf16* CUb = (bf16*)(F.ws + WS_CU);
    bf16* Kb = (bf16*)(F.ws + WS_K); bf16* Vb = (bf16*)(F.ws + WS_V); bf16* GBb = (bf16*)(F.ws + WS_GB);
    bf16* QO = (bf16*)F.outb; bf16* GAb = (bf16*)(F.outb + 64 * MiB);
    float* X1 = (float*)F.outb;
    const LAS int* pfx = (const LAS int*)(F.lds + PFX_OFF);

    if (IN(0)) { p0_prologue(F); if (BOTH(0)) { VM_WAIT(); cg::this_grid().sync(); } }

    if (IN(1)) {
        SchedPlain S{(const char*)H, (const char*)(F.ws + WS_WIN), M / 256, NCOL / 256, F.G, (int)blockIdx.x, TSTEP1024};
        EpiG1 E{Bb, CUb, QO, Kb, Vb, GAb, GBb};
        pg8::gemm_phase<EpiG1, SchedPlain, false>(F.lds, D, S, E);
        if (BOTH(1)) GRID_BAR();
    }
    if (IN(2)) {
        attn_phase(F, QO, Kb, Vb, F.in[6]);
        conv_phase(F, Bb, CUb, H, F.in[3], F.in[4]);
        if (BOTH(2)) GRID_BAR();
    }
    if (IN(3)) {
        SchedDual S{(const char*)H, (long)((const char*)QO - (const char*)H), (const char*)(F.ws + WS_WA), (long)(WS_WB - WS_WA), M / 256, D / 256, F.G, (int)blockIdx.x};
        EpiG3 E{GAb, GBb, Bb};
        pg8::gemm_phase<EpiG3, SchedDual, false>(F.lds, D, S, E);
        if (BOTH(3)) GRID_BAR();
    }
    if (IN(4)) {
        SchedPlain S{(const char*)Bb, (const char*)(F.ws + WS_WO), M / 256, D / 256, F.G, (int)blockIdx.x, TSTEP1024};
        EpiG4 E{F.in[0], X1, H};
        pg8::gemm_phase<EpiG4, SchedPlain, false>(F.lds, D, S, E);
        if (BOTH(4)) GRID_BAR();
    }
    if (IN(5)) { router_phase(F, X1); if (BOTH(5)) GRID_BAR(); }
    if (IN(6) || IN(7)) {
        if (F.tid == 0) { LAS int* p = (LAS int*)(F.lds + PFX_OFF); int run = 0;
            for (int e = 0; e < NEXP; ++e) { const int c = (int)__hip_atomic_load((unsigned*)(F.ctl + CW_CNT + e), RLX_AGENT); p[e] = run; p[40 + e] = c; run += (c + 255) >> 8; }
            p[32] = run; }
        __syncthreads();
    }
    if (IN(6)) {
        SchedMoE S{(const char*)H, (const char*)(F.ws + WS_WGU), pfx, (const int*)(F.ws + WS_LTOK), F.G, (int)blockIdx.x, D, 0, (size_t)D * D * 2, TSTEP1024, true};
        EpiG6 E{(const float*)(F.ws + WS_LR), (const float*)(F.ws + WS_LW), Bb};
        pg8::gemm_phase<EpiG6, SchedMoE, true>(F.lds, D, S, E);
        if (BOTH(6)) GRID_BAR();
    }
    if (IN(7)) {
        SchedMoE S{(const char*)Bb, (const char*)(F.ws + WS_WD), pfx, (const int*)(F.ws + WS_LTOK), F.G, (int)blockIdx.x, FF, (size_t)256 * FF * 2, (size_t)D * FF * 2, (size_t)256 * FF * 2, false};
        EpiG7 E{(const int*)(F.ws + WS_LTOK), (bf16*)(F.ws + WS_PAIRS)};
        pg8::gemm_phase<EpiG7, SchedMoE, false>(F.lds, FF, S, E);
        if (BOTH(7)) GRID_BAR();
    }
    if (IN(8)) final_phase(F, X1, (const bf16*)(F.ws + WS_PAIRS), F.in[17]);
#undef IN
#undef BOTH
#undef GRID_BAR
}

extern "C" void kernel_launch(void* const* d_in, const int* in_sizes, int n_in, void* d_out, int out_size, void* d_ws, size_t ws_size, hipStream_t stream) {
    static int grid = 0;
    if (grid == 0) {
        if (n_in != 18 || in_sizes[0] != M * D || out_size != M * D || ws_size < WS_END) { fprintf(stderr, "kernel_launch: unexpected shapes (n_in %d, ws %zu)\n", n_in, ws_size); grid = -1; return; }
        int dev = 0, cus = 0, per_cu = 0;
        if (hipGetDevice(&dev) != hipSuccess || hipDeviceGetAttribute(&cus, hipDeviceAttributeMultiprocessorCount, dev) != hipSuccess) { grid = -1; return; }
        if (hipFuncSetAttribute((const void*)mk_fwd, hipFuncAttributeMaxDynamicSharedMemorySize, LDS_BYTES) != hipSuccess) { fprintf(stderr, "kernel_launch: hipFuncSetAttribute failed\n"); grid = -1; return; }
        if (hipOccupancyMaxActiveBlocksPerMultiprocessor(&per_cu, (const void*)mk_fwd, NWAVES * 64, LDS_BYTES) != hipSuccess || per_cu < 1) { fprintf(stderr, "kernel_launch: occupancy query says %d\n", per_cu); (void)hipGetLastError(); grid = -1; return; }
        if (per_cu > 1) per_cu = 1;
        grid = cus * per_cu;
    }
    if (grid < 0) return;
    (void)hipMemsetAsync((char*)d_ws + WS_CTL, 0, CTL_ZERO_BYTES, stream);
    Args a{};
    for (int i = 0; i < 18; ++i) a.in[i] = (const float*)d_in[i];
    a.out = (float*)d_out; a.ws = (unsigned char*)d_ws;
    if (N_LAUNCHES == 1) {
        a.ph_lo = 0; a.ph_hi = N_PHASES;
        void* kargs[] = {&a};
        hipError_t e = hipLaunchCooperativeKernel((const void*)mk_fwd, dim3(grid), dim3(NWAVES * 64), kargs, LDS_BYTES, stream);
        if (e != hipSuccess) fprintf(stderr, "kernel_launch: cooperative launch failed: %s (grid %d)\n", hipGetErrorString(e), grid);
    } else {
        for (int li = 0; li < N_PHASES; ++li) { a.ph_lo = li; a.ph_hi = li + 1;
            hipLaunchKernelGGL(mk_fwd, dim3(grid), dim3(NWAVES * 64), LDS_BYTES, stream, a); }
    }
}
```

```cpp
#include <hip/hip_runtime.h>
#include <hip/hip_cooperative_groups.h>
#include <cstdio>
#include <cstdint>
namespace cg = cooperative_groups;

#ifndef MK_N_LAUNCHES
#define MK_N_LAUNCHES 1
#endif
constexpr int N_LAUNCHES = MK_N_LAUNCHES;
constexpr int N_PHASES = 9;

#define GAS __attribute__((address_space(1)))
#define LAS __attribute__((address_space(3)))
typedef unsigned short bf16;
typedef short bf16x8 __attribute__((ext_vector_type(8)));
typedef short s16x4 __attribute__((ext_vector_type(4)));
typedef float f32x4 __attribute__((ext_vector_type(4)));
typedef float f32x2 __attribute__((ext_vector_type(2)));
typedef float f32x16 __attribute__((ext_vector_type(16)));
typedef unsigned u32x4 __attribute__((ext_vector_type(4)));
typedef unsigned u32x2 __attribute__((ext_vector_type(2)));
typedef GAS unsigned gu32;

constexpr int D = 1024, BATCH = 4, SEQ = 8192, M = BATCH * SEQ;
constexpr int NCOL = 6656, NHEAD = 16, HD = 64, NKV = 4, KVW = 256;
constexpr int NEXP = 32, NGRP = 4, EPG = 8, FF = 512, CAP = 32768;
constexpr float EPS = 1e-6f;
constexpr float LOG2E = 1.4426950408889634f;
constexpr float QSCALE = 0.125f * LOG2E;
constexpr int NWAVES = 8;

constexpr size_t MiB = 1u << 20;
constexpr size_t WS_CTL = 0, CTL_ZERO_BYTES = 1 * MiB;
constexpr size_t WS_RWF = 1 * MiB;
constexpr size_t WS_WIN = 2 * MiB;
constexpr size_t WS_WA = 15 * MiB, WS_WB = 17 * MiB, WS_WO = 19 * MiB;
constexpr size_t WS_WGU = 21 * MiB;
constexpr size_t WS_WD = 85 * MiB;
constexpr size_t WS_LTOK = 117 * MiB, WS_LR = 121 * MiB, WS_LW = 125 * MiB;
constexpr size_t WS_H = 129 * MiB;
constexpr size_t WS_B = 193 * MiB;
constexpr size_t WS_CU = 257 * MiB;
constexpr size_t WS_K = 321 * MiB, WS_V = 337 * MiB;
constexpr size_t WS_GB = 353 * MiB;
constexpr size_t WS_PAIRS = 321 * MiB;
constexpr size_t WS_END = 449 * MiB;

constexpr int CW_TMO = 0;
constexpr int CW_CNT = 64;
constexpr int CW_BAR = 4096;

constexpr int RING_BYTES = 131072;
constexpr int LDSCTL_OFF = RING_BYTES, MISC_OFF = LDSCTL_OFF + 320, PFX_OFF = LDSCTL_OFF + 512;
constexpr int LDS_BYTES = 147456;

#define RLX_AGENT __ATOMIC_RELAXED, __HIP_MEMORY_SCOPE_AGENT
#define LDS_WAIT() asm volatile("s_waitcnt lgkmcnt(0)" ::: "memory")
#define VM_WAIT() asm volatile("s_waitcnt vmcnt(0)" ::: "memory")
__device__ __forceinline__ unsigned f2bf(float f) { unsigned u = __builtin_bit_cast(unsigned, f); return (u + 0x7fffu + ((u >> 16) & 1u)) >> 16; }
__device__ __forceinline__ unsigned pk2(float lo, float hi) { return f2bf(lo) | (f2bf(hi) << 16); }
__device__ __forceinline__ float bf2f(unsigned short b) { return __builtin_bit_cast(float, (unsigned)b << 16); }
__device__ __forceinline__ float bflo(unsigned w) { return __builtin_bit_cast(float, w << 16); }
__device__ __forceinline__ float bfhi(unsigned w) { return __builtin_bit_cast(float, w & 0xffff0000u); }
__device__ __forceinline__ unsigned cvt_pk_bf16(float lo, float hi) { unsigned r; asm volatile("v_cvt_pk_bf16_f32 %0, %1, %2" : "=v"(r) : "v"(lo), "v"(hi)); return r; }
__device__ __forceinline__ float fast_sigmoid(float x) { return __builtin_amdgcn_rcpf(1.0f + __builtin_amdgcn_exp2f(-LOG2E * x)); }

#define XB_TMO      128
#define XB_XCNT(j)  (256  + 64 * (j))
#define XB_XSUB(j)  (1280 + 64 * (j))
#define XB_XGEN(j)  (2304 + 64 * (j))
#define XB_TOP      3328
#define XB_TOPGEN   3392
#define XCD_BAR_WORDS 3456
#define XB_SPIN_CAP (1u << 18)
__device__ __forceinline__ unsigned xb_ld(unsigned* p)              { return __hip_atomic_load(p, __ATOMIC_RELAXED, __HIP_MEMORY_SCOPE_AGENT); }
__device__ __forceinline__ unsigned xb_add(unsigned* p, unsigned v) { return __hip_atomic_fetch_add(p, v, __ATOMIC_RELAXED, __HIP_MEMORY_SCOPE_AGENT); }
__device__ __forceinline__ unsigned xb_xcc_id() { return (unsigned)__builtin_amdgcn_s_getreg((3 << 11) | 20) & 0xFu; }
#define XB_SPIN(cond, bar) do { unsigned _sp = 0; while (cond) { __builtin_amdgcn_s_sleep(1); \
    if ((++_sp & 255u) == 0u) { if (xb_ld(&(bar)[XB_TMO])) break; if (_sp > XB_SPIN_CAP) { atomicAdd(&(bar)[XB_TMO], 1u); break; } } } } while (0)
struct XcdBarrier { unsigned* bar; unsigned x; volatile LAS unsigned* st; };
__device__ __forceinline__ XcdBarrier xcd_barrier_post(unsigned* bar, volatile LAS unsigned* st) {
    XcdBarrier b; b.bar = bar; b.x = xb_xcc_id(); b.st = st;
    if (threadIdx.x == 0) (void)xb_add(&bar[XB_XCNT(b.x)], 1u);
    return b;
}
__device__ __forceinline__ void xcd_barrier_complete(unsigned* bar, unsigned x, unsigned& nloc, unsigned& nx) {
    const unsigned G = gridDim.x * gridDim.y * gridDim.z;
    unsigned sum, cnt, mine, sp = 0u;
    for (;;) {
        sum = 0u; cnt = 0u; mine = 0u;
#pragma unroll
        for (unsigned j = 0; j < 16; ++j) { const unsigned c = xb_ld(&bar[XB_XCNT(j)]); sum += c; cnt += (c > 0u) ? 1u : 0u; mine = (j == x) ? c : mine; }
        if (sum == G) break;
        __builtin_amdgcn_s_sleep(1);
        if ((++sp & 255u) == 0u) { if (xb_ld(&bar[XB_TMO])) break; if (sp > XB_SPIN_CAP) { atomicAdd(&bar[XB_TMO], 1u); break; } }
    }
    nloc = mine > 0u ? mine : 1u; nx = cnt > 0u ? cnt : 1u;
}
__device__ __forceinline__ void xcd_barrier(const XcdBarrier& b) {
    asm volatile("s_waitcnt vmcnt(0)" ::: "memory");
    __syncthreads();
    if (threadIdx.x == 0) {
        unsigned* bar = b.bar;
        __builtin_amdgcn_s_waitcnt(0);
        unsigned nloc = b.st[0], nx = b.st[1];
        if (nloc == 0u) { xcd_barrier_complete(bar, b.x, nloc, nx); b.st[0] = nloc; b.st[1] = nx; }
        const unsigned old = xb_add(&bar[XB_XSUB(b.x)], 1u);
        const unsigned gen = old / nloc;
        if (old + 1u == (gen + 1u) * nloc) {
            __builtin_amdgcn_fence(__ATOMIC_RELEASE, "agent");
            asm volatile("s_waitcnt vmcnt(0)" ::: "memory");
            const unsigned og = xb_add(&bar[XB_TOP], 1u);
            const unsigned tg = og / nx;
            if (og + 1u == (tg + 1u) * nx) xb_add(&bar[XB_TOPGEN], 1u);
            else XB_SPIN(xb_ld(&bar[XB_TOPGEN]) == tg, bar);
            __builtin_amdgcn_fence(__ATOMIC_ACQUIRE, "agent");
            xb_add(&bar[XB_XGEN(b.x)], 1u);
            asm volatile("s_waitcnt vmcnt(0)" ::: "memory");
        } else {
            XB_SPIN(xb_ld(&bar[XB_XGEN(b.x)]) == gen, bar);
            __builtin_amdgcn_fence(__ATOMIC_ACQUIRE, "agent");
            asm volatile("s_waitcnt vmcnt(0)" ::: "memory");
        }
    }
    __syncthreads();
}

namespace pg8 {
constexpr int BM = 256, BK = 64, HALF = 128, HTB = HALF * BK * 2, NXCD = 8, WGM = 8;
__host__ __device__ __forceinline__ int lds_byte(int r, int c) { const int st = (r >> 4) * 2 + (c >> 5), rr = r & 15, cc = c & 31, ob = rr * 64 + cc * 2; return st * 1024 + (ob ^ (((ob >> 9) & 1) << 5)); }
__host__ __device__ __forceinline__ void stage_rc(int b, int& R, int& C) { const int st = b / 1024, sb = b % 1024, swz = sb ^ (((sb >> 9) & 1) << 5); R = (st >> 1) * 16 + swz / 64; C = (st & 1) * 32 + (swz % 64) / 2; }
__host__ __device__ __forceinline__ int perm32(int rho) { const int n = rho >> 4, i = rho & 15; return 8 * (i >> 2) + 4 * n + (i & 3); }

struct Unit { int pm, pn, x0, x1, x2; };
__device__ __forceinline__ bool static_unit(long L, int nM, int nN, int& pm, int& pn) {
    const int nwg = nM * nN; if (L >= nwg) return false;
    int wgid = (int)L; { const int q = nwg / NXCD, r = nwg % NXCD, xcd = wgid % NXCD, off = wgid / NXCD; wgid = (xcd < r ? xcd * (q + 1) : r * (q + 1) + (xcd - r) * q) + off; }
    const int nig = WGM * nN, gid = wgid / nig, fm = gid * WGM, gsz = (nM - fm) < WGM ? (nM - fm) : WGM;
    pm = fm + ((wgid % nig) % gsz); pn = (wgid % nig) / gsz; return true;
}

template <class Epi, class Sched, bool GATHER>
__device__ __forceinline__ void gemm_phase(LAS unsigned char* lds, const int K, const Sched& S, const Epi& E) {
    const int tid = threadIdx.x, wid = __builtin_amdgcn_readfirstlane(tid >> 6), lane = tid & 63, wr = wid >> 2, wc = wid & 3, fr = lane & 15, fq = lane >> 4;
    const int nt = K / BK;
    const size_t kstep = (size_t)(BK * 2);
    const size_t hstep = (size_t)HALF * K * 2;
    unsigned voffB[2], aoC[2][2], aoN[2][2]; int Rl[2], Cb[2];
#pragma unroll
    for (int i = 0; i < 2; ++i) { int R, C; stage_rc(tid * 16 + i * 8192, R, C); const int Rb = (R & ~31) + perm32(R & 31);
        voffB[i] = (unsigned)(Rb * K + C) * 2u; Rl[i] = R; Cb[i] = C * 2;
        aoC[0][i] = (unsigned)(R * K + C) * 2u; aoC[1][i] = aoC[0][i] + (unsigned)hstep; aoN[0][i] = aoC[0][i]; aoN[1][i] = aoC[1][i]; }
    const unsigned ldsw = (unsigned)wid * 1024u;
    const int aoff = lds_byte(wr * 64 + fr, fq * 8), boff = lds_byte(wc * 32 + fr, fq * 8);
#define PG8_SA(b, h) (((b) * 2 + (h)) * HTB)
#define PG8_SB(b, h) ((4 + (b) * 2 + (h)) * HTB)
#define PG8_STAGE(bufoff, gbase, voff) do { _Pragma("unroll") for (int _i = 0; _i < 2; ++_i) \
        __builtin_amdgcn_global_load_lds((const unsigned*)((const char*)(gbase) + (voff)[_i]), (LAS unsigned*)(lds + (bufoff) + ldsw + _i * 8192), 16, 0, 0); } while (0)
#define PG8_LDA(dst, b, h) do { _Pragma("unroll") for (int m = 0; m < 4; ++m) _Pragma("unroll") for (int k = 0; k < 2; ++k) dst[m][k] = *(const LAS bf16x8*)(lds + PG8_SA(b, h) + aoff + m * 2048 + k * 1024); } while (0)
#define PG8_LDB(dst, b, h) do { _Pragma("unroll") for (int n = 0; n < 2; ++n) _Pragma("unroll") for (int k = 0; k < 2; ++k) dst[n][k] = *(const LAS bf16x8*)(lds + PG8_SB(b, h) + boff + n * 2048 + k * 1024); } while (0)
#define PG8_MMA(ai, bj, At, Bt) do { __builtin_amdgcn_s_setprio(1); _Pragma("unroll") for (int m = 0; m < 4; ++m) _Pragma("unroll") for (int n = 0; n < 2; ++n) _Pragma("unroll") for (int k = 0; k < 2; ++k) \
        acc[ai][bj][m][n] = __builtin_amdgcn_mfma_f32_16x16x32_bf16(Bt[n][k], At[m][k], acc[ai][bj][m][n], 0, 0, 0); __builtin_amdgcn_s_setprio(0); } while (0)
#define PG8_WAIT_V(n) asm volatile("s_waitcnt vmcnt(" #n ")" ::: "memory")
#define PG8_WAIT_L(n) asm volatile("s_waitcnt lgkmcnt(" #n ")" ::: "memory")
#define PG8_BAR __builtin_amdgcn_s_barrier()
#define PG8_SCHED __builtin_amdgcn_sched_barrier(0)
    Unit cur, nxt; int ui = 0;
    if (!S.next(0, cur)) return;
    f32x4 acc[2][2][4][2];
#pragma unroll
    for (int a = 0; a < 2; ++a)
#pragma unroll
        for (int b = 0; b < 2; ++b)
#pragma unroll
            for (int m = 0; m < 4; ++m)
#pragma unroll
                for (int n = 0; n < 2; ++n) acc[a][b][m][n] = (f32x4){0.f, 0.f, 0.f, 0.f};
    bf16x8 At[4][2], B0[2][2], B1[2][2];
    const char* cA = S.a_base(cur); const char* cB = S.b_base(cur);
    if constexpr (GATHER) S.rows(cur, Rl, Cb, aoC);
    PG8_STAGE(PG8_SB(0, 0), cB, voffB); PG8_STAGE(PG8_SB(0, 1), cB + hstep, voffB); PG8_STAGE(PG8_SA(0, 0), cA, aoC[0]); PG8_STAGE(PG8_SA(0, 1), cA, aoC[1]);
    if (wr == 1) PG8_BAR;
    PG8_WAIT_V(2); PG8_BAR;
    PG8_STAGE(PG8_SB(1, 0), cB + kstep, voffB); PG8_STAGE(PG8_SA(1, 0), cA + kstep, aoC[0]); PG8_STAGE(PG8_SB(1, 1), cB + hstep + kstep, voffB);
    PG8_WAIT_V(6); PG8_BAR;
    for (;;) {
        const bool has_next = S.next(ui + 1, nxt);
        const char* nA = has_next ? S.a_base(nxt) : cA; const char* nB = has_next ? S.b_base(nxt) : cB;
        if constexpr (GATHER) { if (has_next) S.rows(nxt, Rl, Cb, aoN); else { aoN[0][0] = aoC[0][0]; aoN[0][1] = aoC[0][1]; aoN[1][0] = aoC[1][0]; aoN[1][1] = aoC[1][1]; } }
        for (int t = 0; t < nt; t += 2) {
            const bool last = (t == nt - 2);
            const char* a1 = cA + (size_t)(t + 1) * kstep;
            const char* a2 = last ? nA : cA + (size_t)(t + 2) * kstep; const char* b2 = last ? nB : cB + (size_t)(t + 2) * kstep;
            const char* a3 = a2 + kstep; const char* b3 = b2 + kstep;
            unsigned o2[2][2];
            if constexpr (GATHER) { o2[0][0] = last ? aoN[0][0] : aoC[0][0]; o2[0][1] = last ? aoN[0][1] : aoC[0][1]; o2[1][0] = last ? aoN[1][0] : aoC[1][0]; o2[1][1] = last ? aoN[1][1] : aoC[1][1]; }
            else { o2[0][0] = aoC[0][0]; o2[0][1] = aoC[0][1]; o2[1][0] = aoC[1][0]; o2[1][1] = aoC[1][1]; }
            PG8_LDB(B0, 0, 0); PG8_LDB(B1, 0, 1); PG8_SCHED; PG8_LDA(At, 0, 0); PG8_STAGE(PG8_SA(1, 1), a1, aoC[1]);
            PG8_WAIT_V(8); PG8_WAIT_L(0); PG8_BAR; PG8_MMA(0, 0, At, B0); PG8_MMA(0, 1, At, B1); PG8_BAR; PG8_SCHED;
            PG8_LDA(At, 0, 1); PG8_STAGE(PG8_SB(0, 0), b2, voffB); PG8_STAGE(PG8_SB(0, 1), b2 + hstep, voffB); PG8_STAGE(PG8_SA(0, 0), a2, o2[0]);
            PG8_WAIT_V(8); PG8_WAIT_L(0); PG8_BAR; PG8_MMA(1, 0, At, B0); PG8_MMA(1, 1, At, B1); PG8_BAR; PG8_SCHED;
            PG8_LDB(B0, 1, 0); PG8_LDB(B1, 1, 1); PG8_SCHED; PG8_LDA(At, 1, 0); PG8_STAGE(PG8_SA(0, 1), a2, o2[1]);
            PG8_WAIT_V(8); PG8_WAIT_L(0); PG8_BAR; PG8_MMA(0, 0, At, B0); PG8_MMA(0, 1, At, B1); PG8_BAR; PG8_SCHED;
            PG8_LDA(At, 1, 1); PG8_STAGE(PG8_SB(1, 0), b3, voffB); PG8_STAGE(PG8_SB(1, 1), b3 + hstep, voffB); PG8_STAGE(PG8_SA(1, 0), a3, o2[0]);
            PG8_WAIT_V(8); PG8_WAIT_L(0); PG8_BAR; PG8_MMA(1, 0, At, B0); PG8_MMA(1, 1, At, B1); PG8_BAR; PG8_SCHED;
        }
        if (wr == 0) PG8_BAR;
        E(acc, cur, wr, wc, fr, fq);
        if (!has_next) break;
        if (!E.keep(cur)) {
#pragma unroll
            for (int a = 0; a < 2; ++a)
#pragma unroll
                for (int b = 0; b < 2; ++b)
#pragma unroll
                    for (int m = 0; m < 4; ++m)
#pragma unroll
                        for (int n = 0; n < 2; ++n) acc[a][b][m][n] = (f32x4){0.f, 0.f, 0.f, 0.f};
        }
        cur = nxt; cA = nA; cB = nB; ++ui;
        if constexpr (GATHER) { aoC[0][0] = aoN[0][0]; aoC[0][1] = aoN[0][1]; aoC[1][0] = aoN[1][0]; aoC[1][1] = aoN[1][1]; }
        if (wr == 1) PG8_BAR;
    }
    PG8_WAIT_V(0);
    PG8_BAR;
#undef PG8_SA
#undef PG8_SB
#undef PG8_STAGE
#undef PG8_LDA
#undef PG8_LDB
#undef PG8_MMA
#undef PG8_WAIT_V
#undef PG8_WAIT_L
#undef PG8_BAR
#undef PG8_SCHED
}
}
using pg8::Unit;

struct Frame {
    LAS unsigned char* lds;
    volatile LAS unsigned* MISC;
    gu32* ctl;
    int tid, lane, wave, vcu, G;
    unsigned char* ws; unsigned char* outb;
    const float* in[18];
};

__device__ __forceinline__ float wave_sum(float v) {
#pragma unroll
    for (int o = 1; o < 64; o <<= 1) v += __shfl_xor(v, o);
    return v;
}

__device__ __forceinline__ void tr_item(const float* W, int ldw, int k0, int n0, bf16* WT, int Kd, int drow0, const float* gain, LAS float* scr, int lane) {
#pragma unroll 8
    for (int i = 0; i < 32; ++i) { const int kk = 2 * i + (lane >> 5); float v = W[(size_t)(k0 + kk) * ldw + n0 + (lane & 31)]; if (gain) v *= gain[k0 + kk]; scr[kk * 33 + (lane & 31)] = v; }
    LDS_WAIT(); asm volatile("" ::: "memory");
    const int c = lane & 7;
#pragma unroll
    for (int j = 0; j < 4; ++j) { const int n = (lane >> 3) + 8 * j; const LAS float* s = scr + (8 * c) * 33 + n;
        u32x4 o; o.x = pk2(s[0 * 33], s[1 * 33]); o.y = pk2(s[2 * 33], s[3 * 33]); o.z = pk2(s[4 * 33], s[5 * 33]); o.w = pk2(s[6 * 33], s[7 * 33]);
        *(GAS u32x4*)(WT + (size_t)(drow0 + n) * Kd + k0 + 8 * c) = o; }
    LDS_WAIT(); asm volatile("" ::: "memory");
}

__device__ __forceinline__ void p0_prologue(Frame& F) {
    LAS float* scr = (LAS float*)(F.lds + F.wave * 16384);
    const int gw = F.vcu * NWAVES + F.wave, NGW = F.G * NWAVES;
    const float* w_in = F.in[2]; const float* w_a = F.in[5]; const float* w_b = F.in[7]; const float* w_o = F.in[8];
    const float* w_gate = F.in[14]; const float* w_up = F.in[15]; const float* w_down = F.in[16]; const float* g_ffn = F.in[9];
    bf16* WIN = (bf16*)(F.ws + WS_WIN); bf16* WA = (bf16*)(F.ws + WS_WA); bf16* WB = (bf16*)(F.ws + WS_WB); bf16* WO = (bf16*)(F.ws + WS_WO);
    bf16* WGU = (bf16*)(F.ws + WS_WGU); bf16* WD = (bf16*)(F.ws + WS_WD);
    constexpr int I_IN = 16 * 208, I_SQ = 16 * 32, I_G = 32 * 16 * 16, I_D = 32 * 8 * 32;
    constexpr int NITEMS = I_IN + 3 * I_SQ + 2 * I_G + I_D;
    for (int it = gw; it < NITEMS; it += NGW) {
        int r = it;
        if (r < I_IN) { const int kb = r / 208, nb = r % 208, n0 = 32 * nb; int dr = n0;
            if (n0 >= 1024 && n0 < 2048) { const int ch = n0 - 1024; dr = 1024 + 256 * (ch >> 7) + (ch & 127); }
            else if (n0 >= 2048 && n0 < 3072) { const int ch = n0 - 2048; dr = 1024 + 256 * (ch >> 7) + 128 + (ch & 127); }
            tr_item(w_in, NCOL, 64 * kb, n0, WIN, D, dr, nullptr, scr, F.lane); continue; } r -= I_IN;
        if (r < I_SQ) { tr_item(w_a, D, 64 * (r / 32), 32 * (r % 32), WA, D, 32 * (r % 32), nullptr, scr, F.lane); continue; } r -= I_SQ;
        if (r < I_SQ) { tr_item(w_b, D, 64 * (r / 32), 32 * (r % 32), WB, D, 32 * (r % 32), nullptr, scr, F.lane); continue; } r -= I_SQ;
        if (r < I_SQ) { tr_item(w_o, D, 64 * (r / 32), 32 * (r % 32), WO, D, 32 * (r % 32), nullptr, scr, F.lane); continue; } r -= I_SQ;
        if (r < I_G) { const int e = r / 256, q = r % 256, kb = q / 16, nb = q % 16, f0 = 32 * nb;
            tr_item(w_gate + (size_t)e * D * FF, FF, 64 * kb, f0, WGU + (size_t)e * D * D, D, 256 * (f0 >> 7) + (f0 & 127), g_ffn, scr, F.lane); continue; } r -= I_G;
        if (r < I_G) { const int e = r / 256, q = r % 256, kb = q / 16, nb = q % 16, f0 = 32 * nb;
            tr_item(w_up + (size_t)e * D * FF, FF, 64 * kb, f0, WGU + (size_t)e * D * D, D, 256 * (f0 >> 7) + 128 + (f0 & 127), g_ffn, scr, F.lane); continue; } r -= I_G;
        { const int e = r / 256, q = r % 256, kb = q / 32, nb = q % 32;
            tr_item(w_down + (size_t)e * FF * D, D, 64 * kb, 32 * nb, WD + (size_t)e * D * FF, FF, 32 * nb, nullptr, scr, F.lane); }
    }
    { const float* x = F.in[0]; const float* g = F.in[1]; bf16* H = (bf16*)(F.ws + WS_H);
      f32x4 gv[4];
#pragma unroll
      for (int j = 0; j < 4; ++j) gv[j] = *((const GAS f32x4*)g + F.lane + 64 * j);
      for (int m = gw; m < M; m += NGW) {
        const GAS f32x4* xr = (const GAS f32x4*)(x + (size_t)m * D) + F.lane;
        f32x4 v[4]; float s = 0.f;
#pragma unroll
        for (int j = 0; j < 4; ++j) { v[j] = xr[64 * j]; s += (v[j].x * v[j].x + v[j].y * v[j].y) + (v[j].z * v[j].z + v[j].w * v[j].w); }
        const float rs = 1.0f / sqrtf(wave_sum(s) * (1.f / D) + EPS);
        GAS u32x2* o8 = (GAS u32x2*)(H + (size_t)m * D) + F.lane;
#pragma unroll
        for (int j = 0; j < 4; ++j) { u32x2 w; w.x = pk2(v[j].x * rs * gv[j].x, v[j].y * rs * gv[j].y); w.y = pk2(v[j].z * rs * gv[j].z, v[j].w * rs * gv[j].w); o8[64 * j] = w; }
      } }
    { const float* wg = F.in[10]; const float* we = F.in[12]; u32x4* RWF = (u32x4*)(F.ws + WS_RWF);
      const int gt = F.vcu * (NWAVES * 64) + F.tid, NGT = F.G * NWAVES * 64;
      for (int idx = gt; idx < 32 * 3 * 64; idx += NGT) {
        const int l = idx & 63, st = idx >> 6, t = st % 3, s = st / 3, col = 16 * t + (l & 15), k0 = 32 * s + 8 * (l >> 4);
        unsigned hi[8], lo[8];
#pragma unroll
        for (int j = 0; j < 8; ++j) { const int k = k0 + j; float w = 0.f;
            if (col < 4) w = wg[k * 4 + col]; else if (col < 36) w = we[k * 32 + col - 4];
            w *= g_ffn[k]; const unsigned h = f2bf(w); hi[j] = h; lo[j] = f2bf(w - bf2f((unsigned short)h)); }
        u32x4 vh, vl; vh.x = hi[0] | (hi[1] << 16); vh.y = hi[2] | (hi[3] << 16); vh.z = hi[4] | (hi[5] << 16); vh.w = hi[6] | (hi[7] << 16);
        vl.x = lo[0] | (lo[1] << 16); vl.y = lo[2] | (lo[3] << 16); vl.z = lo[4] | (lo[5] << 16); vl.w = lo[6] | (lo[7] << 16);
        RWF[((size_t)st * 2 + 0) * 64 + l] = vh; RWF[((size_t)st * 2 + 1) * 64 + l] = vl; } }
}

constexpr size_t TSTEP1024 = (size_t)256 * 1024 * 2;
struct SchedPlain {
    const char* A; const char* Bt; int nM, nN, G, c; size_t tstep;
    __device__ __forceinline__ bool next(int i, Unit& u) const { u.x0 = 0; u.x1 = 0; u.x2 = 0; return pg8::static_unit((long)i * G + c, nM, nN, u.pm, u.pn); }
    __device__ __forceinline__ const char* a_base(const Unit& u) const { return A + (size_t)u.pm * tstep; }
    __device__ __forceinline__ const char* b_base(const Unit& u) const { return Bt + (size_t)u.pn * tstep; }
    __device__ __forceinline__ void rows(const Unit&, const int*, const int*, unsigned (&)[2][2]) const {}
};
struct SchedDual {
    const char* A0; long dA; const char* B0; long dB; int nM, nN, G, c;
    __device__ __forceinline__ bool next(int i, Unit& u) const { u.x0 = i & 1; u.x1 = 0; u.x2 = 0; return pg8::static_unit((long)(i >> 1) * G + c, nM, nN, u.pm, u.pn); }
    __device__ __forceinline__ const char* a_base(const Unit& u) const { return A0 + ((-(long)u.x0) & dA) + (size_t)u.pm * TSTEP1024; }
    __device__ __forceinline__ const char* b_base(const Unit& u) const { return B0 + ((-(long)u.x0) & dB) + (size_t)u.pn * TSTEP1024; }
    __device__ __forceinline__ void rows(const Unit&, const int*, const int*, unsigned (&)[2][2]) const {}
};
struct SchedMoE {
    const char* A; const char* Bt; const LAS int* pfx; const int* ltok; int G, c; int K; size_t a_tstep, b_estep, b_tstep; bool gather;
    __device__ __forceinline__ bool next(int i, Unit& u) const {
        const int nM = pfx[32];
        if (!pg8::static_unit((long)i * G + c, nM, 4, u.pm, u.pn)) return false;
        int e = 0;
#pragma unroll 1
        for (int j = 1; j < NEXP; ++j) if (pfx[j] <= u.pm) e = j;
        e = __builtin_amdgcn_readfirstlane(e);
        const int mt = u.pm - pfx[e];
        u.x0 = e; u.x1 = pfx[40 + e] - 256 * mt; u.x2 = e * CAP + 256 * mt; return true;
    }
    __device__ __forceinline__ const char* a_base(const Unit& u) const { return gather ? A : A + (size_t)u.pm * a_tstep; }
    __device__ __forceinline__ const char* b_base(const Unit& u) const { return Bt + (size_t)u.x0 * b_estep + (size_t)u.pn * b_tstep; }
    __device__ __forceinline__ void rows(const Unit& u, const int* Rl, const int* Cb, unsigned (&off)[2][2]) const {
#pragma unroll
        for (int h = 0; h < 2; ++h)
#pragma unroll
            for (int i = 0; i < 2; ++i) { const int rl = h * 128 + Rl[i]; int tok = 0; if (rl < u.x1) tok = ltok[u.x2 + rl] >> 1; off[h][i] = (unsigned)tok * (unsigned)(K * 2) + (unsigned)Cb[i]; }
    }
};

struct EpiG1 {
    bf16 *Bo, *CUo, *Qo, *Ko, *Vo, *GAo, *GBo;
    __device__ __forceinline__ bool keep(const Unit&) const { return false; }
    __device__ __forceinline__ void operator()(f32x4 (&acc)[2][2][4][2], const Unit& u, int wr, int wc, int fr, int fq) const {
        const int row0 = u.pm * 256 + wr * 64 + fr, pn = u.pn, cb = wc * 32 + 8 * fq;
        if (pn >= 4 && pn < 12) {
#pragma unroll
            for (int ai = 0; ai < 2; ++ai)
#pragma unroll
                for (int m = 0; m < 4; ++m) { bf16* rowp = CUo + (size_t)(row0 + ai * 128 + m * 16) * D + 128 * (pn - 4) + cb;
                    const f32x4 v0 = acc[ai][0][m][0] * acc[ai][1][m][0], v1 = acc[ai][0][m][1] * acc[ai][1][m][1];
                    u32x4 w; w.x = cvt_pk_bf16(v0[0], v0[1]); w.y = cvt_pk_bf16(v0[2], v0[3]); w.z = cvt_pk_bf16(v1[0], v1[1]); w.w = cvt_pk_bf16(v1[2], v1[3]);
                    *(u32x4*)rowp = w; }
            return;
        }
        bf16* base; int ldc = D, col = cb; int mode = 0; float sc = 1.f;
        if (pn < 4) { base = Bo; col += 256 * pn; }
        else if (pn < 16) { base = Qo; col += 256 * (pn - 12); sc = QSCALE; }
        else if (pn == 16) { base = Ko; ldc = KVW; }
        else if (pn == 17) { base = Vo; ldc = KVW; }
        else if (pn < 22) { base = GAo; col += 256 * (pn - 18); mode = 1; }
        else { base = GBo; col += 256 * (pn - 22); mode = 1; }
#pragma unroll
        for (int ai = 0; ai < 2; ++ai)
#pragma unroll
            for (int m = 0; m < 4; ++m) { bf16* rowp = base + (size_t)(row0 + ai * 128 + m * 16) * ldc + col;
#pragma unroll
                for (int bj = 0; bj < 2; ++bj) { f32x4 v0 = acc[ai][bj][m][0], v1 = acc[ai][bj][m][1];
                    if (mode == 1) {
#pragma unroll
                        for (int q = 0; q < 4; ++q) { v0[q] = fast_sigmoid(v0[q]); v1[q] = fast_sigmoid(v1[q]); } }
                    else { v0 = v0 * sc; v1 = v1 * sc; }
                    u32x4 w; w.x = cvt_pk_bf16(v0[0], v0[1]); w.y = cvt_pk_bf16(v0[2], v0[3]); w.z = cvt_pk_bf16(v1[0], v1[1]); w.w = cvt_pk_bf16(v1[2], v1[3]);
                    *(u32x4*)(rowp + bj * 128) = w; } }
    }
};
struct EpiG3 {
    const bf16* GA; const bf16* GB; bf16* MO;
    __device__ __forceinline__ bool keep(const Unit& u) const { return u.x0 == 0; }
    __device__ __forceinline__ void operator()(f32x4 (&acc)[2][2][4][2], const Unit& u, int wr, int wc, int fr, int fq) const {
        const int row0 = u.pm * 256 + wr * 64 + fr, col0 = u.pn * 256 + wc * 32 + 8 * fq; const bool s0 = (u.x0 == 0);
#pragma unroll
        for (int ai = 0; ai < 2; ++ai)
#pragma unroll
            for (int m = 0; m < 4; ++m) { const size_t off = (size_t)(row0 + ai * 128 + m * 16) * D + col0;
#pragma unroll
                for (int bj = 0; bj < 2; ++bj) {
                    const u32x4 gb = *(const u32x4*)(GB + off + bj * 128);
                    float b[8] = {bflo(gb.x), bfhi(gb.x), bflo(gb.y), bfhi(gb.y), bflo(gb.z), bfhi(gb.z), bflo(gb.w), bfhi(gb.w)};
#pragma unroll
                    for (int q = 0; q < 8; ++q) b[q] = fmaxf(b[q], 1e-30f);
                    if (s0) { const u32x4 ga = *(const u32x4*)(GA + off + bj * 128);
                        const float a[8] = {bflo(ga.x), bfhi(ga.x), bflo(ga.y), bfhi(ga.y), bflo(ga.z), bfhi(ga.z), bflo(ga.w), bfhi(ga.w)};
#pragma unroll
                        for (int q = 0; q < 4; ++q) { acc[ai][bj][m][0][q] *= a[q] * __builtin_amdgcn_rcpf(b[q]); acc[ai][bj][m][1][q] *= a[4 + q] * __builtin_amdgcn_rcpf(b[4 + q]); }
                    } else {
                        f32x4 v0 = acc[ai][bj][m][0], v1 = acc[ai][bj][m][1];
#pragma unroll
                        for (int q = 0; q < 4; ++q) { v0[q] *= b[q]; v1[q] *= b[4 + q]; }
                        u32x4 w; w.x = cvt_pk_bf16(v0[0], v0[1]); w.y = cvt_pk_bf16(v0[2], v0[3]); w.z = cvt_pk_bf16(v1[0], v1[1]); w.w = cvt_pk_bf16(v1[2], v1[3]);
                        *(u32x4*)(MO + off + bj * 128) = w; } } }
    }
};
struct EpiG4 {
    const float* X; float* X1; bf16* X1B;
    __device__ __forceinline__ bool keep(const Unit&) const { return false; }
    __device__ __forceinline__ void operator()(f32x4 (&acc)[2][2][4][2], const Unit& u, int wr, int wc, int fr, int fq) const {
        const int row0 = u.pm * 256 + wr * 64 + fr, col0 = u.pn * 256 + wc * 32 + 8 * fq;
#pragma unroll
        for (int ai = 0; ai < 2; ++ai)
#pragma unroll
            for (int m = 0; m < 4; ++m) { const size_t off = (size_t)(row0 + ai * 128 + m * 16) * D + col0;
#pragma unroll
                for (int bj = 0; bj < 2; ++bj) {
                    const f32x4 x0 = *(const f32x4*)(X + off + bj * 128), x1 = *(const f32x4*)(X + off + bj * 128 + 4);
                    const f32x4 v0 = acc[ai][bj][m][0] + x0, v1 = acc[ai][bj][m][1] + x1;
                    *(f32x4*)(X1 + off + bj * 128) = v0; *(f32x4*)(X1 + off + bj * 128 + 4) = v1;
                    u32x4 w; w.x = cvt_pk_bf16(v0[0], v0[1]); w.y = cvt_pk_bf16(v0[2], v0[3]); w.z = cvt_pk_bf16(v1[0], v1[1]); w.w = cvt_pk_bf16(v1[2], v1[3]);
                    *(u32x4*)(X1B + off + bj * 128) = w; }
                if (m & 1) asm volatile("" ::: "memory"); }
    }
};
struct EpiG6 {
    const float* LR; const float* LW; bf16* ACT;
    __device__ __forceinline__ bool keep(const Unit&) const { return false; }
    __device__ __forceinline__ void operator()(f32x4 (&acc)[2][2][4][2], const Unit& u, int wr, int wc, int fr, int fq) const {
        const int rl0 = wr * 64 + fr, col0 = u.pn * 128 + wc * 32 + 8 * fq;
#pragma unroll
        for (int ai = 0; ai < 2; ++ai)
#pragma unroll
            for (int m = 0; m < 4; ++m) { const int rl = rl0 + ai * 128 + m * 16; float rs = 0.f, wsv = 0.f;
                if (rl < u.x1) { rs = LR[u.x2 + rl]; wsv = LW[u.x2 + rl]; }
                float o[8];
#pragma unroll
                for (int n = 0; n < 2; ++n)
#pragma unroll
                    for (int q = 0; q < 4; ++q) { const float g = acc[ai][0][m][n][q] * rs, up = acc[ai][1][m][n][q] * rs; o[4 * n + q] = wsv * g * fast_sigmoid(g) * up; }
                u32x4 w; w.x = cvt_pk_bf16(o[0], o[1]); w.y = cvt_pk_bf16(o[2], o[3]); w.z = cvt_pk_bf16(o[4], o[5]); w.w = cvt_pk_bf16(o[6], o[7]);
                *(u32x4*)(ACT + (size_t)(u.pm * 256 + rl) * FF + col0) = w; }
    }
};
struct EpiG7 {
    const int* LT; bf16* PAIRS;
    __device__ __forceinline__ bool keep(const Unit&) const { return false; }
    __device__ __forceinline__ void operator()(f32x4 (&acc)[2][2][4][2], const Unit& u, int wr, int wc, int fr, int fq) const {
        const int rl0 = wr * 64 + fr, col0 = u.pn * 256 + wc * 32 + 8 * fq;
#pragma unroll
        for (int ai = 0; ai < 2; ++ai)
#pragma unroll
            for (int m = 0; m < 4; ++m) { const int rl = rl0 + ai * 128 + m * 16;
                if (rl < u.x1) { const int pid = LT[u.x2 + rl]; bf16* rowp = PAIRS + (size_t)pid * D + col0;
#pragma unroll
                    for (int bj = 0; bj < 2; ++bj) { const f32x4 v0 = acc[ai][bj][m][0], v1 = acc[ai][bj][m][1];
                        u32x4 w; w.x = cvt_pk_bf16(v0[0], v0[1]); w.y = cvt_pk_bf16(v0[2], v0[3]); w.z = cvt_pk_bf16(v1[0], v1[1]); w.w = cvt_pk_bf16(v1[2], v1[3]);
                        *(u32x4*)(rowp + bj * 128) = w; } } }
    }
};

constexpr int KP = 144;
constexpr int ATT_K_OFF = 0, ATT_V_OFF = 256 * KP;
__device__ __forceinline__ s16x4 vtr(const LAS unsigned char* p) { return __builtin_bit_cast(s16x4, __builtin_amdgcn_ds_read_tr16_b64_v4i16((LAS s16x4*)p)); }

__device__ __forceinline__ void attn_phase(Frame& F, bf16* QO, const bf16* Kg, const bf16* Vg, const float* sinks) {
    LAS unsigned char* Kl = F.lds + ATT_K_OFF; LAS unsigned char* Vl = F.lds + ATT_V_OFF;
    const int tid = F.tid, lane = F.lane, wid = F.wave, r32 = lane & 31, hi = lane >> 5;
    for (int u = F.vcu; u < BATCH * (SEQ / 128) * NKV; u += F.G) {
        const int kh = u & 3, n = (u >> 2) & 63, b = u >> 8;
        const int T0 = b * SEQ + n * 128;
        u32x4 kv[4], vv[4];
#pragma unroll
        for (int i = 0; i < 4; ++i) { const int piece = tid + 512 * i, row = piece >> 3, c = piece & 7; const bool ok = (n > 0) || (row >= 128);
            const long tok = (long)T0 - 128 + row;
            kv[i] = (u32x4){0u, 0u, 0u, 0u}; vv[i] = (u32x4){0u, 0u, 0u, 0u};
            if (ok) { kv[i] = *(const u32x4*)(Kg + tok * KVW + kh * 64 + c * 8); vv[i] = *(const u32x4*)(Vg + tok * KVW + kh * 64 + c * 8); } }
#pragma unroll
        for (int i = 0; i < 4; ++i) { const int piece = tid + 512 * i, row = piece >> 3, c = piece & 7;
            *(LAS u32x4*)(Kl + row * KP + c * 16) = kv[i];
            *(LAS u32x4*)(Vl + row * 128 + ((c * 16) ^ (((row >> 1) & 1) << 6))) = vv[i]; }
        __syncthreads();
        const int g = wid >> 1, head = kh * 4 + g;
        const float slope2 = __builtin_amdgcn_exp2f(-0.5f * (float)(head + 1)) * LOG2E;
        const float sink2 = sinks[head] * LOG2E;
#pragma unroll 1
        for (int p = 0; p < 2; ++p) {
            const int qs = 2 * (wid & 1) + p;
            const long qrow = (long)T0 + 32 * qs + r32;
            bf16* qp = QO + qrow * D + head * 64;
            bf16x8 qf[4];
#pragma unroll
            for (int ks = 0; ks < 4; ++ks) qf[ks] = *(const bf16x8*)(qp + 16 * ks + 8 * hi);
            f32x16 s[5];
#pragma unroll
            for (int ti = 0; ti < 5; ++ti) { const LAS unsigned char* kb = Kl + (32 * (qs + ti) + r32) * KP + 16 * hi;
                f32x16 a = {};
#pragma unroll
                for (int ks = 0; ks < 4; ++ks) { const bf16x8 kf = *(const LAS bf16x8*)(kb + 32 * ks); a = __builtin_amdgcn_mfma_f32_32x32x16_bf16(kf, qf[ks], a, 0, 0, 0); }
                s[ti] = a; }
            const float base = slope2 * (float)(4 * hi - r32 - 128);
            float mx = -INFINITY;
#pragma unroll
            for (int ti = 0; ti < 5; ++ti) { const bool dead = (n == 0) && (qs + ti < 4);
#pragma unroll
                for (int r = 0; r < 16; ++r) { const int ro = (r & 3) + 8 * (r >> 2); float v = s[ti][r] + (slope2 * (float)(32 * ti + ro) + base);
                    const int rel0 = ro + 4 * hi - r32;
                    bool ok = !dead;
                    if (ti == 0) ok = ok && (rel0 >= 1);
                    if (ti == 4) ok = ok && (rel0 <= 0);
                    v = ok ? v : -INFINITY; s[ti][r] = v; mx = fmaxf(mx, v); } }
            mx = fmaxf(mx, __shfl_xor(mx, 32)); mx = fmaxf(mx, sink2);
            float sum = 0.f;
#pragma unroll
            for (int ti = 0; ti < 5; ++ti)
#pragma unroll
                for (int r = 0; r < 16; ++r) { const float e = __builtin_amdgcn_exp2f(s[ti][r] - mx); s[ti][r] = e; sum += e; }
            sum += __shfl_xor(sum, 32);
            const float inv = 1.0f / (sum + __builtin_amdgcn_exp2f(sink2 - mx));
            f32x16 o[2]; o[0] = (f32x16){}; o[1] = (f32x16){};
            const int i16 = lane & 15, gsel = (lane >> 4) & 1;
            const int vcol = (gsel * 16 + 4 * (i16 & 3)) * 2;
            const int vswz = ((i16 >> 3) & 1) << 6;
#pragma unroll
            for (int ti = 0; ti < 5; ++ti)
#pragma unroll
                for (int s2 = 0; s2 < 2; ++s2) {
                    u32x4 pw; pw.x = cvt_pk_bf16(s[ti][8 * s2 + 0], s[ti][8 * s2 + 1]); pw.y = cvt_pk_bf16(s[ti][8 * s2 + 2], s[ti][8 * s2 + 3]);
                    pw.z = cvt_pk_bf16(s[ti][8 * s2 + 4], s[ti][8 * s2 + 5]); pw.w = cvt_pk_bf16(s[ti][8 * s2 + 6], s[ti][8 * s2 + 7]);
                    const bf16x8 pf = __builtin_bit_cast(bf16x8, pw);
                    const int key0 = 32 * (qs + ti) + 16 * s2 + 4 * hi + (i16 >> 2);
#pragma unroll
                    for (int dt = 0; dt < 2; ++dt) {
                        const LAS unsigned char* vp = Vl + key0 * 128 + ((dt * 64 + vcol) ^ vswz);
                        const s16x4 lo = vtr(vp), hh = vtr(vp + 8 * 128);
                        const bf16x8 vf = (bf16x8){lo[0], lo[1], lo[2], lo[3], hh[0], hh[1], hh[2], hh[3]};
                        o[dt] = __builtin_amdgcn_mfma_f32_32x32x16_bf16(vf, pf, o[dt], 0, 0, 0); } }
#pragma unroll
            for (int dt = 0; dt < 2; ++dt)
#pragma unroll
                for (int rq = 0; rq < 4; ++rq) { u32x2 w; w.x = cvt_pk_bf16(o[dt][4 * rq] * inv, o[dt][4 * rq + 1] * inv); w.y = cvt_pk_bf16(o[dt][4 * rq + 2] * inv, o[dt][4 * rq + 3] * inv);
                    *(u32x2*)(qp + 32 * dt + 8 * rq + 4 * hi) = w; }
        }
        __syncthreads();
    }
}

__device__ __forceinline__ void conv_phase(Frame& F, const bf16* Bg, const bf16* CUg, bf16* YC, const float* cw, const float* cbias) {
    const int gw = F.vcu * NWAVES + F.wave, NGW = F.G * NWAVES;
    for (int it = gw; it < (M / 32) * 2; it += NGW) {
        const int half = it & 1, t0 = (it >> 1) * 32, c0 = half * 512 + F.lane * 8;
        float w0[8], w1[8], w2[8], cb[8], p1[8], p2[8];
#pragma unroll
        for (int q = 0; q < 8; ++q) { w0[q] = cw[c0 + q]; w1[q] = cw[D + c0 + q]; w2[q] = cw[2 * D + c0 + q]; cb[q] = cbias[c0 + q]; p1[q] = 0.f; p2[q] = 0.f; }
        if ((t0 & (SEQ - 1)) != 0) {
            const u32x4 a = *(const u32x4*)(CUg + (size_t)(t0 - 1) * D + c0), c = *(const u32x4*)(CUg + (size_t)(t0 - 2) * D + c0);
            p1[0] = bflo(a.x); p1[1] = bfhi(a.x); p1[2] = bflo(a.y); p1[3] = bfhi(a.y); p1[4] = bflo(a.z); p1[5] = bfhi(a.z); p1[6] = bflo(a.w); p1[7] = bfhi(a.w);
            p2[0] = bflo(c.x); p2[1] = bfhi(c.x); p2[2] = bflo(c.y); p2[3] = bfhi(c.y); p2[4] = bflo(c.z); p2[5] = bfhi(c.z); p2[6] = bflo(c.w); p2[7] = bfhi(c.w);
        }
#pragma unroll 4
        for (int t = 0; t < 32; ++t) {
            const u32x4 a = *(const u32x4*)(CUg + (size_t)(t0 + t) * D + c0), bb = *(const u32x4*)(Bg + (size_t)(t0 + t) * D + c0);
            const float cu[8] = {bflo(a.x), bfhi(a.x), bflo(a.y), bfhi(a.y), bflo(a.z), bfhi(a.z), bflo(a.w), bfhi(a.w)};
            const float bv[8] = {bflo(bb.x), bfhi(bb.x), bflo(bb.y), bfhi(bb.y), bflo(bb.z), bfhi(bb.z), bflo(bb.w), bfhi(bb.w)};
            float y[8];
#pragma unroll
            for (int q = 0; q < 8; ++q) { y[q] = bv[q] * (w0[q] * p2[q] + w1[q] * p1[q] + w2[q] * cu[q] + cb[q]); p2[q] = p1[q]; p1[q] = cu[q]; }
            u32x4 w; w.x = pk2(y[0], y[1]); w.y = pk2(y[2], y[3]); w.z = pk2(y[4], y[5]); w.w = pk2(y[6], y[7]);
            *(u32x4*)(YC + (size_t)(t0 + t) * D + c0) = w;
        }
    }
}

__device__ __forceinline__ void router_phase(Frame& F, const float* X1) {
    const int lane = F.lane, wid = F.wave, tid = F.tid;
    LAS float* lg = (LAS float*)(F.lds + wid * 3072);
    LAS int* lcnt = (LAS int*)(F.lds + 32768); LAS int* lbase = lcnt + 32;
    const u32x4* RWF = (const u32x4*)(F.ws + WS_RWF);
    const float* bg = F.in[11]; const float* be = F.in[13];
    int* LT = (int*)(F.ws + WS_LTOK); float* LR = (float*)(F.ws + WS_LR); float* LW = (float*)(F.ws + WS_LW);
    for (int tb = F.vcu; tb < M / 128; tb += F.G) {
        if (tid < 32) lcnt[tid] = 0;
        __syncthreads();
        const int tok0 = tb * 128 + wid * 16, row = lane & 15, kg = lane >> 4;
        const float* xr = X1 + (size_t)(tok0 + row) * D + 8 * kg;
        f32x4 acc[3]; acc[0] = (f32x4){0.f, 0.f, 0.f, 0.f}; acc[1] = acc[0]; acc[2] = acc[0];
        float ss = 0.f;
#pragma unroll 4
        for (int s = 0; s < 32; ++s) {
            const f32x4 a0 = *(const f32x4*)(xr + 32 * s), a1 = *(const f32x4*)(xr + 32 * s + 4);
            ss += (a0.x * a0.x + a0.y * a0.y) + (a0.z * a0.z + a0.w * a0.w) + (a1.x * a1.x + a1.y * a1.y) + (a1.z * a1.z + a1.w * a1.w);
            const float xv[8] = {a0.x, a0.y, a0.z, a0.w, a1.x, a1.y, a1.z, a1.w};
            unsigned h[8], l[8];
#pragma unroll
            for (int j = 0; j < 8; ++j) { h[j] = f2bf(xv[j]); l[j] = f2bf(xv[j] - bf2f((unsigned short)h[j])); }
            u32x4 ah, al; ah.x = h[0] | (h[1] << 16); ah.y = h[2] | (h[3] << 16); ah.z = h[4] | (h[5] << 16); ah.w = h[6] | (h[7] << 16);
            al.x = l[0] | (l[1] << 16); al.y = l[2] | (l[3] << 16); al.z = l[4] | (l[5] << 16); al.w = l[6] | (l[7] << 16);
            const bf16x8 Ah = __builtin_bit_cast(bf16x8, ah), Al = __builtin_bit_cast(bf16x8, al);
#pragma unroll
            for (int t = 0; t < 3; ++t) {
                const bf16x8 Bh = __builtin_bit_cast(bf16x8, RWF[((size_t)(s * 3 + t) * 2 + 0) * 64 + lane]);
                const bf16x8 Bl = __builtin_bit_cast(bf16x8, RWF[((size_t)(s * 3 + t) * 2 + 1) * 64 + lane]);
                acc[t] = __builtin_amdgcn_mfma_f32_16x16x32_bf16(Ah, Bh, acc[t], 0, 0, 0);
                acc[t] = __builtin_amdgcn_mfma_f32_16x16x32_bf16(Al, Bh, acc[t], 0, 0, 0);
                acc[t] = __builtin_amdgcn_mfma_f32_16x16x32_bf16(Ah, Bl, acc[t], 0, 0, 0);
            }
        }
#pragma unroll
        for (int t = 0; t < 3; ++t)
#pragma unroll
            for (int i = 0; i < 4; ++i) lg[(4 * kg + i) * 48 + 16 * t + row] = acc[t][i];
        ss += __shfl_xor(ss, 16); ss += __shfl_xor(ss, 32);
        const float rr = 1.0f / sqrtf(ss * (1.f / D) + EPS);
        LDS_WAIT(); asm volatile("" ::: "memory");
        int e0 = 0, e1 = 0, rank0 = 0, rank1 = 0; float w0 = 0.f, w1 = 0.f;
        if (lane < 16) {
            const LAS float* my = lg + lane * 48;
            float gl[4];
#pragma unroll
            for (int j = 0; j < 4; ++j) gl[j] = rr * my[j] + bg[j];
            int gi = 0; float gm = gl[0];
#pragma unroll
            for (int j = 1; j < 4; ++j) if (gl[j] > gm) { gm = gl[j]; gi = j; }
            float den = 0.f;
#pragma unroll
            for (int j = 0; j < 4; ++j) den += __expf(gl[j] - gm);
            const float pg = 1.0f / den;
            float v0 = -INFINITY, v1 = -INFINITY; int i0 = 0, i1 = 0;
#pragma unroll
            for (int i = 0; i < 8; ++i) { const float v = rr * my[4 + 8 * gi + i] + be[8 * gi + i];
                if (v > v0) { v1 = v0; i1 = i0; v0 = v; i0 = i; } else if (v > v1) { v1 = v; i1 = i; } }
            const float ex = __expf(v1 - v0), s0 = 1.0f / (1.0f + ex);
            w0 = pg * s0; w1 = pg * (ex * s0);
            e0 = 8 * gi + i0; e1 = 8 * gi + i1;
            rank0 = __hip_atomic_fetch_add(lcnt + e0, 1, __ATOMIC_RELAXED, __HIP_MEMORY_SCOPE_WORKGROUP); rank1 = __hip_atomic_fetch_add(lcnt + e1, 1, __ATOMIC_RELAXED, __HIP_MEMORY_SCOPE_WORKGROUP);
        }
        __syncthreads();
        if (tid < 32) { const int c = lcnt[tid]; int bs = 0; if (c > 0) bs = (int)__hip_atomic_fetch_add((unsigned*)(F.ctl + CW_CNT + tid), (unsigned)c, RLX_AGENT); lbase[tid] = bs; }
        __syncthreads();
        if (lane < 16) { const int tok = tok0 + lane;
            const int p0 = e0 * CAP + lbase[e0] + rank0, p1 = e1 * CAP + lbase[e1] + rank1;
            LT[p0] = tok * 2; LR[p0] = rr; LW[p0] = w0;
            LT[p1] = tok * 2 + 1; LR[p1] = rr; LW[p1] = w1; }
        __syncthreads();
    }
}

__device__ __forceinline__ void final_phase(Frame& F, float* X1, const bf16* PAIRS, const float* g) {
    const int gw = F.vcu * NWAVES + F.wave, NGW = F.G * NWAVES;
    f32x4 gv[4];
#pragma unroll
    for (int j = 0; j < 4; ++j) gv[j] = *((const GAS f32x4*)g + F.lane + 64 * j);
    for (int m = gw; m < M; m += NGW) {
        GAS f32x4* xr = (GAS f32x4*)(X1 + (size_t)m * D) + F.lane;
        const GAS u32x2* pa = (const GAS u32x2*)(PAIRS + (size_t)(2 * m) * D) + F.lane; const GAS u32x2* pb = (const GAS u32x2*)(PAIRS + (size_t)(2 * m + 1) * D) + F.lane;
        f32x4 v[4]; float s = 0.f;
#pragma unroll
        for (int j = 0; j < 4; ++j) { v[j] = xr[64 * j]; const u32x2 a = pa[64 * j], b = pb[64 * j];
            v[j].x += bflo(a.x) + bflo(b.x); v[j].y += bfhi(a.x) + bfhi(b.x); v[j].z += bflo(a.y) + bflo(b.y); v[j].w += bfhi(a.y) + bfhi(b.y);
            s += (v[j].x * v[j].x + v[j].y * v[j].y) + (v[j].z * v[j].z + v[j].w * v[j].w); }
        const float rs = 1.0f / sqrtf(wave_sum(s) * (1.f / D) + EPS);
#pragma unroll
        for (int j = 0; j < 4; ++j) xr[64 * j] = v[j] * rs * gv[j];
    }
}

struct Args { const float* in[18]; float* out; unsigned char* ws; int ph_lo, ph_hi; };
__global__ void __launch_bounds__(NWAVES * 64, 2) mk_fwd(Args args) {
    extern __shared__ __attribute__((aligned(16))) unsigned char lds[];
    Frame F;
    F.lds = (LAS unsigned char*)lds;
    F.MISC = (volatile LAS unsigned*)(F.lds + MISC_OFF);
    F.tid = threadIdx.x; F.lane = F.tid & 63; F.wave = __builtin_amdgcn_readfirstlane(F.tid >> 6);
    F.G = gridDim.x; { const int bx = blockIdx.x; F.vcu = (F.G % 8 == 0) ? (bx % 8) * (F.G / 8) + bx / 8 : bx; }
    F.ws = args.ws; F.outb = (unsigned char*)args.out; F.ctl = (gu32*)(args.ws + WS_CTL);
#pragma unroll
    for (int i = 0; i < 18; ++i) F.in[i] = args.in[i];
    for (int u = F.tid; u < (LDS_BYTES - LDSCTL_OFF) / 4; u += NWAVES * 64) ((LAS unsigned*)(F.lds + LDSCTL_OFF))[u] = 0u;
    __syncthreads();
    XcdBarrier bar; bar.bar = (unsigned*)(F.ctl + CW_BAR); bar.x = 0; bar.st = nullptr;
    if (N_LAUNCHES == 1) bar = xcd_barrier_post((unsigned*)(F.ctl + CW_BAR), F.MISC + 8);
    const int lo = args.ph_lo, hi = args.ph_hi;
#define IN(k) (lo <= (k) && (k) < hi)
#define BOTH(k) (IN(k) && IN((k) + 1))
#define GRID_BAR() xcd_barrier(bar)

    bf16* H = (bf16*)(F.ws + WS_H); bf16* Bb = (bf16*)(F.ws + WS_B); bf16* CUb = (bf16*)(F.ws + WS_CU);
    bf16* Kb = (bf16*)(F.ws + WS_K); bf16* Vb = (bf16*)(F.ws + WS_V); bf16* GBb = (bf16*)(F.ws + WS_GB);
    bf16* QO = (bf16*)F.outb; bf16* GAb = (bf16*)(F.outb + 64 * MiB);
    float* X1 = (float*)F.outb;
    const LAS int* pfx = (const LAS int*)(F.lds + PFX_OFF);

    if (IN(0)) { p0_prologue(F); if (BOTH(0)) { VM_WAIT(); cg::this_grid().sync(); } }

    if (IN(1)) {
        SchedPlain S{(const char*)H, (const char*)(F.ws + WS_WIN), M / 256, NCOL / 256, F.G, (int)blockIdx.x, TSTEP1024};
        EpiG1 E{Bb, CUb, QO, Kb, Vb, GAb, GBb};
        pg8::gemm_phase<EpiG1, SchedPlain, false>(F.lds, D, S, E);
        if (BOTH(1)) GRID_BAR();
    }
    if (IN(2)) {
        attn_phase(F, QO, Kb, Vb, F.in[6]);
        conv_phase(F, Bb, CUb, H, F.in[3], F.in[4]);
        if (BOTH(2)) GRID_BAR();
    }
    if (IN(3)) {
        SchedDual S{(const char*)H, (long)((const char*)QO - (const char*)H), (const char*)(F.ws + WS_WA), (long)(WS_WB - WS_WA), M / 256, D / 256, F.G, (int)blockIdx.x};
        EpiG3 E{GAb, GBb, Bb};
        pg8::gemm_phase<EpiG3, SchedDual, false>(F.lds, D, S, E);
        if (BOTH(3)) GRID_BAR();
    }
    if (IN(4)) {
        SchedPlain S{(const char*)Bb, (const char*)(F.ws + WS_WO), M / 256, D / 256, F.G, (int)blockIdx.x, TSTEP1024};
        EpiG4 E{F.in[0], X1, H};
        pg8::gemm_phase<EpiG4, SchedPlain, false>(F.lds, D, S, E);
        if (BOTH(4)) GRID_BAR();
    }
    if (IN(5)) { router_phase(F, X1); if (BOTH(5)) GRID_BAR(); }
    if (IN(6) || IN(7)) {
        if (F.tid == 0) { LAS int* p = (LAS int*)(F.lds + PFX_OFF); int run = 0;
            for (int e = 0; e < NEXP; ++e) { const int c = (int)__hip_atomic_load((unsigned*)(F.ctl + CW_CNT + e), RLX_AGENT); p[e] = run; p[40 + e] = c; run += (c + 255) >> 8; }
            p[32] = run; }
        __syncthreads();
    }
    if (IN(6)) {
        SchedMoE S{(const char*)H, (const char*)(F.ws + WS_WGU), pfx, (const int*)(F.ws + WS_LTOK), F.G, (int)blockIdx.x, D, 0, (size_t)D * D * 2, TSTEP1024, true};
        EpiG6 E{(const float*)(F.ws + WS_LR), (const float*)(F.ws + WS_LW), Bb};
        pg8::gemm_phase<EpiG6, SchedMoE, true>(F.lds, D, S, E);
        if (BOTH(6)) GRID_BAR();
    }
    if (IN(7)) {
        SchedMoE S{(const char*)Bb, (const char*)(F.ws + WS_WD), pfx, (const int*)(F.ws + WS_LTOK), F.G, (int)blockIdx.x, FF, (size_t)256 * FF * 2, (size_t)D * FF * 2, (size_t)256 * FF * 2, false};
        EpiG7 E{(const int*)(F.ws + WS_LTOK), (bf16*)(F.ws + WS_PAIRS)};
        pg8::gemm_phase<EpiG7, SchedMoE, false>(F.lds, FF, S, E);
        if (BOTH(7)) GRID_BAR();
    }
    if (IN(8)) final_phase(F, X1, (const bf16*)(F.ws + WS_PAIRS), F.in[17]);
#undef IN
#undef BOTH
#undef GRID_BAR
}

extern "C" void kernel_launch(void* const* d_in, const int* in_sizes, int n_in, void* d_out, int out_size, void* d_ws, size_t ws_size, hipStream_t stream) {
    static int grid = 0;
    if (grid == 0) {
        if (n_in != 18 || in_sizes[0] != M * D || out_size != M * D || ws_size < WS_END) { fprintf(stderr, "kernel_launch: unexpected shapes (n_in %d, ws %zu)\n", n_in, ws_size); grid = -1; return; }
        int dev = 0, cus = 0, per_cu = 0;
        if (hipGetDevice(&dev) != hipSuccess || hipDeviceGetAttribute(&cus, hipDeviceAttributeMultiprocessorCount, dev) != hipSuccess) { grid = -1; return; }
        if (hipFuncSetAttribute((const void*)mk_fwd, hipFuncAttributeMaxDynamicSharedMemorySize, LDS_BYTES) != hipSuccess) { fprintf(stderr, "kernel_launch: hipFuncSetAttribute failed\n"); grid = -1; return; }
        if (hipOccupancyMaxActiveBlocksPerMultiprocessor(&per_cu, (const void*)mk_fwd, NWAVES * 64, LDS_BYTES) != hipSuccess || per_cu < 1) { fprintf(stderr, "kernel_launch: occupancy query says %d\n", per_cu); (void)hipGetLastError(); grid = -1; return; }
        if (per_cu > 1) per_cu = 1;
        grid = cus * per_cu;
    }
    if (grid < 0) return;
    (void)hipMemsetAsync((char*)d_ws + WS_CTL, 0, CTL_ZERO_BYTES, stream);
    Args a{};
    for (int i = 0; i < 18; ++i) a.in[i] = (const float*)d_in[i];
    a.out = (float*)d_out; a.ws = (unsigned char*)d_ws;
    if (N_LAUNCHES == 1) {
        a.ph_lo = 0; a.ph_hi = N_PHASES;
        void* kargs[] = {&a};
        hipError_t e = hipLaunchCooperativeKernel((const void*)mk_fwd, dim3(grid), dim3(NWAVES * 64), kargs, LDS_BYTES, stream);
        if (e != hipSuccess) fprintf(stderr, "kernel_launch: cooperative launch failed: %s (grid %d)\n", hipGetErrorString(e), grid);
    } else {
        for (int li = 0; li < N_PHASES; ++li) { a.ph_lo = li; a.ph_hi = li + 1;
            hipLaunchKernelGGL(mk_fwd, dim3(grid), dim3(NWAVES * 64), LDS_BYTES, stream, a); }
    }
}
```

```cpp
#include <hip/hip_runtime.h>
#include <hip/hip_cooperative_groups.h>
#include <cstdio>
#include <cstdint>
namespace cg = cooperative_groups;

#ifndef MK_N_LAUNCHES
#define MK_N_LAUNCHES 1
#endif
constexpr int N_LAUNCHES = MK_N_LAUNCHES;
#ifndef PROBE_K
#define PROBE_K -1
#endif
#define PROBE_MULT 4
#ifndef USE_CG_SYNC
#define USE_CG_SYNC 0
#endif
constexpr int N_PHASES = 9;

#define GAS __attribute__((address_space(1)))
#define LAS __attribute__((address_space(3)))
typedef unsigned short bf16;
typedef short bf16x8 __attribute__((ext_vector_type(8)));
typedef short s16x4 __attribute__((ext_vector_type(4)));
typedef float f32x4 __attribute__((ext_vector_type(4)));
typedef float f32x2 __attribute__((ext_vector_type(2)));
typedef float f32x16 __attribute__((ext_vector_type(16)));
typedef unsigned u32x4 __attribute__((ext_vector_type(4)));
typedef unsigned u32x2 __attribute__((ext_vector_type(2)));
typedef GAS unsigned gu32;
typedef int i32x4 __attribute__((ext_vector_type(4)));
typedef int i32x8 __attribute__((ext_vector_type(8)));

constexpr int D = 1024, BATCH = 4, SEQ = 8192, M = BATCH * SEQ;
constexpr int NCOL = 6656, NHEAD = 16, HD = 64, NKV = 4, KVW = 256;
constexpr int NEXP = 32, NGRP = 4, EPG = 8, FF = 512, CAP = 32768;
constexpr float EPS = 1e-6f;
constexpr float LOG2E = 1.4426950408889634f;
constexpr float QSCALE = 0.125f * LOG2E;
constexpr int NWAVES = 8;

constexpr size_t MiB = 1u << 20;
constexpr size_t WS_CTL = 0, CTL_ZERO_BYTES = 64 * 1024;
constexpr size_t WS_RWF = 1 * MiB;
constexpr size_t WS_WIN = 2 * MiB;
constexpr size_t WS_WA = 15 * MiB, WS_WB = 17 * MiB, WS_WO = 19 * MiB;
constexpr size_t WS_WGU = 21 * MiB;
constexpr size_t WS_WD = 85 * MiB;
constexpr size_t WS_LTOK = 117 * MiB, WS_LR = 121 * MiB, WS_LW = 125 * MiB;
constexpr size_t WS_H = 129 * MiB;
constexpr size_t WS_B = 193 * MiB;
constexpr size_t WS_CU = 257 * MiB;
constexpr size_t WS_K = 321 * MiB, WS_V = 337 * MiB;
constexpr size_t WS_GB = 353 * MiB;
constexpr size_t WS_PAIRS = 321 * MiB;
constexpr size_t WS_B2 = 449 * MiB;
constexpr size_t WS_RI = 450 * MiB;
constexpr size_t WS_X1B = 257 * MiB;
constexpr size_t WS_ACT = 289 * MiB;
constexpr size_t WS_POS = 450 * MiB + 256 * 1024;
constexpr size_t WS_END = 451 * MiB;

constexpr int CW_TMO = 0;
constexpr int CW_CNT = 64;
constexpr int CW_BAR = 4096;

constexpr int RING_BYTES = 131072;
constexpr int LDSCTL_OFF = RING_BYTES, MISC_OFF = LDSCTL_OFF + 320, PFX_OFF = LDSCTL_OFF + 512;
constexpr int CONVW_OFF = LDSCTL_OFF + 1024;
constexpr int T2E_OFF_WORDS = (CONVW_OFF - PFX_OFF) / 4;
constexpr int LDS_BYTES = 163840;

#define RLX_AGENT __ATOMIC_RELAXED, __HIP_MEMORY_SCOPE_AGENT
#define LDS_WAIT() asm volatile("s_waitcnt lgkmcnt(0)" ::: "memory")
#define VM_WAIT() asm volatile("s_waitcnt vmcnt(0)" ::: "memory")
__device__ __forceinline__ unsigned f2bf(float f) { unsigned u = __builtin_bit_cast(unsigned, f); return (u + 0x7fffu + ((u >> 16) & 1u)) >> 16; }
__device__ __forceinline__ unsigned pk2(float lo, float hi) { return f2bf(lo) | (f2bf(hi) << 16); }
__device__ __forceinline__ float bf2f(unsigned short b) { return __builtin_bit_cast(float, (unsigned)b << 16); }
__device__ __forceinline__ float bflo(unsigned w) { return __builtin_bit_cast(float, w << 16); }
__device__ __forceinline__ float bfhi(unsigned w) { return __builtin_bit_cast(float, w & 0xffff0000u); }
__device__ __forceinline__ unsigned cvt_pk_bf16(float lo, float hi) { unsigned r; asm volatile("v_cvt_pk_bf16_f32 %0, %1, %2" : "=v"(r) : "v"(lo), "v"(hi)); return r; }
__device__ __forceinline__ void unpack8(const u32x4& a, float (&f)[8]) { f[0] = bflo(a.x); f[1] = bfhi(a.x); f[2] = bflo(a.y); f[3] = bfhi(a.y); f[4] = bflo(a.z); f[5] = bfhi(a.z); f[6] = bflo(a.w); f[7] = bfhi(a.w); }
__device__ __forceinline__ unsigned pk4_fp8(float a, float b, float c, float d) {
    a = fminf(fmaxf(a, -448.f), 448.f); b = fminf(fmaxf(b, -448.f), 448.f); c = fminf(fmaxf(c, -448.f), 448.f); d = fminf(fmaxf(d, -448.f), 448.f);
    int w = 0; w = __builtin_amdgcn_cvt_pk_fp8_f32(a, b, w, false); w = __builtin_amdgcn_cvt_pk_fp8_f32(c, d, w, true); return (unsigned)w; }
constexpr float W8_SCALE = 32.f;  constexpr int W8_E8M0 = 127 - 5;
constexpr float A8_SCALE = 16.f;  constexpr int A8_E8M0 = 127 - 4;
constexpr float P8_SCALE = 16.f;
__device__ __forceinline__ float fast_sigmoid(float x) { return __builtin_amdgcn_rcpf(1.0f + __builtin_amdgcn_exp2f(-LOG2E * x)); }

#define XB_TMO      128
#define XB_XCNT(j)  (256  + 64 * (j))
#define XB_XSUB(j)  (1280 + 64 * (j))
#define XB_XGEN(j)  (2304 + 64 * (j))
#define XB_TOP      3328
#define XB_TOPGEN   3392
#define XCD_BAR_WORDS 3456
#define XB_SPIN_CAP (1u << 18)
__device__ __forceinline__ unsigned xb_ld(unsigned* p)              { return __hip_atomic_load(p, __ATOMIC_RELAXED, __HIP_MEMORY_SCOPE_AGENT); }
__device__ __forceinline__ unsigned xb_add(unsigned* p, unsigned v) { return __hip_atomic_fetch_add(p, v, __ATOMIC_RELAXED, __HIP_MEMORY_SCOPE_AGENT); }
__device__ __forceinline__ unsigned xb_xcc_id() { return (unsigned)__builtin_amdgcn_s_getreg((3 << 11) | 20) & 0xFu; }
#define XB_SPIN(cond, bar) do { unsigned _sp = 0; while (cond) { __builtin_amdgcn_s_sleep(1); \
    if ((++_sp & 255u) == 0u) { if (xb_ld(&(bar)[XB_TMO])) break; if (_sp > XB_SPIN_CAP) { atomicAdd(&(bar)[XB_TMO], 1u); break; } } } } while (0)
struct XcdBarrier { unsigned* bar; unsigned x; volatile LAS unsigned* st; };
__device__ __forceinline__ XcdBarrier xcd_barrier_post(unsigned* bar, volatile LAS unsigned* st) {
    XcdBarrier b; b.bar = bar; b.x = xb_xcc_id(); b.st = st;
    if (threadIdx.x == 0) (void)xb_add(&bar[XB_XCNT(b.x)], 1u);
    return b;
}
__device__ __forceinline__ void xcd_barrier_complete(unsigned* bar, unsigned x, unsigned& nloc, unsigned& nx) {
    const unsigned G = gridDim.x * gridDim.y * gridDim.z;
    unsigned sum, cnt, mine, sp = 0u;
    for (;;) {
        sum = 0u; cnt = 0u; mine = 0u;
#pragma unroll
        for (unsigned j = 0; j < 16; ++j) { const unsigned c = xb_ld(&bar[XB_XCNT(j)]); sum += c; cnt += (c > 0u) ? 1u : 0u; mine = (j == x) ? c : mine; }
        if (sum == G) break;
        __builtin_amdgcn_s_sleep(1);
        if ((++sp & 255u) == 0u) { if (xb_ld(&bar[XB_TMO])) break; if (sp > XB_SPIN_CAP) { atomicAdd(&bar[XB_TMO], 1u); break; } }
    }
    nloc = mine > 0u ? mine : 1u; nx = cnt > 0u ? cnt : 1u;
}
__device__ __forceinline__ void xcd_barrier(const XcdBarrier& b) {
    asm volatile("s_waitcnt vmcnt(0)" ::: "memory");
    __syncthreads();
    if (threadIdx.x == 0) {
        unsigned* bar = b.bar;
        __builtin_amdgcn_s_waitcnt(0);
        unsigned nloc = b.st[0], nx = b.st[1];
        if (nloc == 0u) { xcd_barrier_complete(bar, b.x, nloc, nx); b.st[0] = nloc; b.st[1] = nx; }
        const unsigned old = xb_add(&bar[XB_XSUB(b.x)], 1u);
        const unsigned gen = old / nloc;
        if (old + 1u == (gen + 1u) * nloc) {
            __builtin_amdgcn_fence(__ATOMIC_RELEASE, "agent");
            asm volatile("s_waitcnt vmcnt(0)" ::: "memory");
            const unsigned og = xb_add(&bar[XB_TOP], 1u);
            const unsigned tg = og / nx;
            if (og + 1u == (tg + 1u) * nx) xb_add(&bar[XB_TOPGEN], 1u);
            else XB_SPIN(xb_ld(&bar[XB_TOPGEN]) == tg, bar);
            __builtin_amdgcn_fence(__ATOMIC_ACQUIRE, "agent");
            xb_add(&bar[XB_XGEN(b.x)], 1u);
            asm volatile("s_waitcnt vmcnt(0)" ::: "memory");
        } else {
            XB_SPIN(xb_ld(&bar[XB_XGEN(b.x)]) == gen, bar);
            __builtin_amdgcn_fence(__ATOMIC_ACQUIRE, "agent");
            asm volatile("s_waitcnt vmcnt(0)" ::: "memory");
        }
    }
    __syncthreads();
}

#define XS_XSUB(s, j) (XCD_BAR_WORDS + (s) * 1152 + 64 * (j))
#define XS_TOP(s)     (XCD_BAR_WORDS + (s) * 1152 + 1024)
#define XS_GEN(s)     (XCD_BAR_WORDS + (s) * 1152 + 1088)
__device__ __forceinline__ void xcd_split_arrive(const XcdBarrier& b, int s) {
    __syncthreads();
    if (threadIdx.x == 0) {
        unsigned* bar = b.bar;
        const unsigned nloc = b.st[0], nx = b.st[1];
        const unsigned old = xb_add(&bar[XS_XSUB(s, b.x)], 1u);
        if (old + 1u == nloc) {
            __builtin_amdgcn_fence(__ATOMIC_RELEASE, "agent");
            asm volatile("s_waitcnt vmcnt(0)" ::: "memory");
            const unsigned og = xb_add(&bar[XS_TOP(s)], 1u);
            if (og + 1u == nx) xb_add(&bar[XS_GEN(s)], 1u);
        }
    }
}
__device__ __forceinline__ void xcd_split_wait(const XcdBarrier& b, int s) {
    if (threadIdx.x == 0) {
        XB_SPIN(xb_ld(&b.bar[XS_GEN(s)]) == 0u, b.bar);
        __builtin_amdgcn_fence(__ATOMIC_ACQUIRE, "agent");
        asm volatile("s_waitcnt vmcnt(0)" ::: "memory");
    }
    __syncthreads();
}

namespace pg8 {
constexpr int BM = 256, BK = 64, HALF = 128, HTB = HALF * BK * 2, NXCD = 8, WGM = 8;
__host__ __device__ __forceinline__ int lds_byte(int r, int c) { const int st = (r >> 4) * 2 + (c >> 5), rr = r & 15, cc = c & 31, ob = rr * 64 + cc * 2; return st * 1024 + (ob ^ (((ob >> 9) & 1) << 5)); }
__host__ __device__ __forceinline__ void stage_rc(int b, int& R, int& C) { const int st = b / 1024, sb = b % 1024, swz = sb ^ (((sb >> 9) & 1) << 5); R = (st >> 1) * 16 + swz / 64; C = (st & 1) * 32 + (swz % 64) / 2; }
__host__ __device__ __forceinline__ int perm32(int rho) { const int n = rho >> 4, i = rho & 15; return 8 * (i >> 2) + 4 * n + (i & 3); }

struct Unit { int pm, pn, x0, x1, x2; };
__device__ __forceinline__ bool static_unit(long L, int nM, int nN, int& pm, int& pn) {
    const int nwg = nM * nN; if (L >= nwg) return false;
    int wgid = (int)L; { const int q = nwg / NXCD, r = nwg % NXCD, xcd = wgid % NXCD, off = wgid / NXCD; wgid = (xcd < r ? xcd * (q + 1) : r * (q + 1) + (xcd - r) * q) + off; }
    const int nig = WGM * nN, gid = wgid / nig, fm = gid * WGM, gsz = (nM - fm) < WGM ? (nM - fm) : WGM;
    const int wi = wgid % nig;
    if (gsz == WGM) { pm = fm + (wi & (WGM - 1)); pn = wi >> 3; }
    else { pm = fm + wi % gsz; pn = wi / gsz; }
    return true;
}

__host__ __device__ __forceinline__ int g8(int r) { return ((r >> 1) & 1) | (((r >> 3) & 1) << 2); }
__device__ __forceinline__ i32x8 cat8(bf16x8 a, bf16x8 b) { const i32x4 x = __builtin_bit_cast(i32x4, a), y = __builtin_bit_cast(i32x4, b); return __builtin_shufflevector(x, y, 0, 1, 2, 3, 4, 5, 6, 7); }
template <class Epi, class Sched, bool GATHER, bool FP8 = false>
__device__ __forceinline__ void gemm_phase(LAS unsigned char* lds, const int K, const Sched& S, const Epi& E, const int sA = 127, const int sB = 127) {
    const int tid = threadIdx.x, wid = __builtin_amdgcn_readfirstlane(tid >> 6), lane = tid & 63, wr = wid >> 2, wc = wid & 3, fr = lane & 15, fq = lane >> 4;
    const int pitch = FP8 ? K : 2 * K;
    int nt = pitch / 128; asm volatile("" : "+s"(nt));
    const size_t kstep = (size_t)128;
    const size_t hstep = (size_t)HALF * pitch;
    unsigned voffB[2], voffBh[2], aoC[2][2], aoN[2][2]; int Rl[2], Cb[2];
#pragma unroll
    for (int i = 0; i < 2; ++i) { int R, C;
        if constexpr (FP8) { const int pb = tid * 16 + i * 8192; R = pb >> 7; C = (((pb >> 4) & 7) ^ g8(R)) * 8; }
        else stage_rc(tid * 16 + i * 8192, R, C);
        const int Rb = (R & ~31) + perm32(R & 31);
        voffB[i] = (unsigned)(Rb * pitch + C * 2); voffBh[i] = voffB[i] + (unsigned)hstep; Rl[i] = R; Cb[i] = C * 2;
        aoC[0][i] = (unsigned)(R * pitch + C * 2); aoC[1][i] = aoC[0][i] + (unsigned)hstep; aoN[0][i] = aoC[0][i]; aoN[1][i] = aoC[1][i]; }
    const unsigned ldsw = (unsigned)wid * 1024u;
    const int aoff = FP8 ? (wr * 64 + fr) * 128 + ((32 * fq) ^ (g8(fr) << 4)) : lds_byte(wr * 64 + fr, fq * 8);
    const int boff = FP8 ? (wc * 32 + fr) * 128 + ((32 * fq) ^ (g8(fr) << 4)) : lds_byte(wc * 32 + fr, fq * 8);
#define PG8_SA(b, h) (((b) * 2 + (h)) * HTB)
#define PG8_SB(b, h) ((4 + (b) * 2 + (h)) * HTB)
#define PG8_STAGE(bufoff, gbase, voff) do { _Pragma("unroll") for (int _i = 0; _i < 2; ++_i) \
        __builtin_amdgcn_global_load_lds((const unsigned*)((const char*)(gbase) + (voff)[_i]), (LAS unsigned*)(lds + (bufoff) + ldsw + _i * 8192), 16, 0, 0); } while (0)
#define PG8_LDA(dst, b, h) do { if constexpr (FP8) { _Pragma("unroll") for (int m = 0; m < 4; ++m) { const i32x4 lo_ = *(const LAS i32x4*)(lds + PG8_SA(b, h) + (aoff + m * 2048)), hi_ = *(const LAS i32x4*)(lds + PG8_SA(b, h) + ((aoff ^ 16) + m * 2048)); \
            dst##_8[m] = __builtin_shufflevector(lo_, hi_, 0, 1, 2, 3, 4, 5, 6, 7); } } \
        else { _Pragma("unroll") for (int m = 0; m < 4; ++m) _Pragma("unroll") for (int k = 0; k < 2; ++k) dst[m][k] = *(const LAS bf16x8*)(lds + PG8_SA(b, h) + aoff + m * 2048 + k * 1024); } } while (0)
#define PG8_LDB(dst, b, h) do { if constexpr (FP8) { _Pragma("unroll") for (int n = 0; n < 2; ++n) { const i32x4 lo_ = *(const LAS i32x4*)(lds + PG8_SB(b, h) + (boff + n * 2048)), hi_ = *(const LAS i32x4*)(lds + PG8_SB(b, h) + ((boff ^ 16) + n * 2048)); \
            dst##_8[n] = __builtin_shufflevector(lo_, hi_, 0, 1, 2, 3, 4, 5, 6, 7); } } \
        else { _Pragma("unroll") for (int n = 0; n < 2; ++n) _Pragma("unroll") for (int k = 0; k < 2; ++k) dst[n][k] = *(const LAS bf16x8*)(lds + PG8_SB(b, h) + boff + n * 2048 + k * 1024); } } while (0)
#define PG8_MMA(ai, bj, At, Bt) do { if constexpr (FP8) __builtin_amdgcn_sched_barrier(0); __builtin_amdgcn_s_setprio(1); \
        if constexpr (FP8) { _Pragma("unroll") for (int m = 0; m < 4; ++m) _Pragma("unroll") for (int n = 0; n < 2; ++n) \
            asm volatile("v_mfma_scale_f32_16x16x128_f8f6f4 %0, %1, %2, %0, %3, %4 op_sel_hi:[0,0,0]" : "+v"(acc[ai][bj][m][n]) : "v"(Bt##_8[n]), "v"(At##_8[m]), "v"(sBv), "v"(sAv)); \
            __builtin_amdgcn_sched_barrier(0); } \
        else { _Pragma("unroll") for (int m = 0; m < 4; ++m) _Pragma("unroll") for (int n = 0; n < 2; ++n) _Pragma("unroll") for (int k = 0; k < 2; ++k) \
            acc[ai][bj][m][n] = __builtin_amdgcn_mfma_f32_16x16x32_bf16(Bt[n][k], At[m][k], acc[ai][bj][m][n], 0, 0, 0); } \
        __builtin_amdgcn_s_setprio(0); } while (0)
#define PG8_WAIT_V(n) asm volatile("s_waitcnt vmcnt(" #n ")" ::: "memory")
#define PG8_WAIT_L(n) asm volatile("s_waitcnt lgkmcnt(" #n ")" ::: "memory")
#define PG8_BAR __builtin_amdgcn_s_barrier()
#define PG8_SCHED __builtin_amdgcn_sched_barrier(0)
    Unit cur, nxt; int ui = 0;
    if (!S.next(0, cur)) return;
    f32x4 acc[2][2][4][2];
#pragma unroll
    for (int a = 0; a < 2; ++a)
#pragma unroll
        for (int b = 0; b < 2; ++b)
#pragma unroll
            for (int m = 0; m < 4; ++m)
#pragma unroll
                for (int n = 0; n < 2; ++n) acc[a][b][m][n] = (f32x4){0.f, 0.f, 0.f, 0.f};
    bf16x8 At[4][2], B0[2][2], B1[2][2]; i32x8 At_8[4], B0_8[2], B1_8[2];
    int sAv = sA, sBv = sB; asm volatile("" : "+v"(sAv), "+v"(sBv));
    const char* cA = S.a_base(cur); const char* cB = S.b_base(cur);
    bool has_next = S.next(1, nxt);
    if constexpr (GATHER) { S.rows(cur, Rl, Cb, aoC); if (has_next) S.rows(nxt, Rl, Cb, aoN); else { aoN[0][0] = aoC[0][0]; aoN[0][1] = aoC[0][1]; aoN[1][0] = aoC[1][0]; aoN[1][1] = aoC[1][1]; } }
    PG8_STAGE(PG8_SB(0, 0), cB, voffB); PG8_STAGE(PG8_SB(0, 1), cB, voffBh); PG8_STAGE(PG8_SA(0, 0), cA, aoC[0]); PG8_STAGE(PG8_SA(0, 1), cA, aoC[1]);
    if (wr == 1) PG8_BAR;
    PG8_WAIT_V(2); PG8_BAR;
    PG8_STAGE(PG8_SB(1, 0), cB + kstep, voffB); PG8_STAGE(PG8_SA(1, 0), cA + kstep, aoC[0]); PG8_STAGE(PG8_SB(1, 1), cB + kstep, voffBh);
    PG8_WAIT_V(6); PG8_BAR;
    for (;;) {
        const char* nA = has_next ? S.a_base(nxt) : cA; const char* nB = has_next ? S.b_base(nxt) : cB;
#pragma unroll 1
        for (int t = 0; t < nt; t += 2) {
            const bool last = (t == nt - 2);
            const char* a1 = cA + (size_t)(t + 1) * kstep;
            const char* a2 = last ? nA : cA + (size_t)(t + 2) * kstep; const char* b2 = last ? nB : cB + (size_t)(t + 2) * kstep;
            const char* a3 = a2 + kstep; const char* b3 = b2 + kstep;
            unsigned o2[2][2];
            if constexpr (GATHER) { o2[0][0] = last ? aoN[0][0] : aoC[0][0]; o2[0][1] = last ? aoN[0][1] : aoC[0][1]; o2[1][0] = last ? aoN[1][0] : aoC[1][0]; o2[1][1] = last ? aoN[1][1] : aoC[1][1]; }
            else { o2[0][0] = aoC[0][0]; o2[0][1] = aoC[0][1]; o2[1][0] = aoC[1][0]; o2[1][1] = aoC[1][1]; }
            PG8_LDB(B0, 0, 0); PG8_LDB(B1, 0, 1); PG8_SCHED; PG8_LDA(At, 0, 0); PG8_STAGE(PG8_SA(1, 1), a1, aoC[1]);
            PG8_WAIT_V(8); PG8_WAIT_L(0); PG8_BAR; PG8_MMA(0, 0, At, B0); PG8_MMA(0, 1, At, B1); PG8_BAR; PG8_SCHED;
            PG8_LDA(At, 0, 1); PG8_STAGE(PG8_SB(0, 0), b2, voffB); PG8_STAGE(PG8_SB(0, 1), b2, voffBh); PG8_STAGE(PG8_SA(0, 0), a2, o2[0]);
            PG8_WAIT_V(8); PG8_WAIT_L(0); PG8_BAR; PG8_MMA(1, 0, At, B0); PG8_MMA(1, 1, At, B1); PG8_BAR; PG8_SCHED;
            PG8_LDB(B0, 1, 0); PG8_LDB(B1, 1, 1); PG8_SCHED; PG8_LDA(At, 1, 0); PG8_STAGE(PG8_SA(0, 1), a2, o2[1]);
            PG8_WAIT_V(8); PG8_WAIT_L(0); PG8_BAR; PG8_MMA(0, 0, At, B0); PG8_MMA(0, 1, At, B1); PG8_BAR; PG8_SCHED;
            PG8_LDA(At, 1, 1); PG8_STAGE(PG8_SB(1, 0), b3, voffB); PG8_STAGE(PG8_SB(1, 1), b3, voffBh); PG8_STAGE(PG8_SA(1, 0), a3, o2[0]);
            PG8_WAIT_V(8); PG8_WAIT_L(0); PG8_BAR; PG8_MMA(1, 0, At, B0); PG8_MMA(1, 1, At, B1); PG8_BAR; PG8_SCHED;
        }
        Unit nn; const bool has_nn = has_next && S.next(ui + 2, nn);
        unsigned aoNN[2][2];
        if constexpr (GATHER) { if (has_nn) S.rows(nn, Rl, Cb, aoNN); else { aoNN[0][0] = aoN[0][0]; aoNN[0][1] = aoN[0][1]; aoNN[1][0] = aoN[1][0]; aoNN[1][1] = aoN[1][1]; } }
        if (wr == 0) PG8_BAR;
        if constexpr (FP8) asm volatile("s_nop 15\n\ts_nop 15" ::: "memory");
        E(acc, cur, wr, wc, fr, fq);
        if (!has_next) break;
        if (!E.keep(cur)) {
#pragma unroll
            for (int a = 0; a < 2; ++a)
#pragma unroll
                for (int b = 0; b < 2; ++b)
#pragma unroll
                    for (int m = 0; m < 4; ++m)
#pragma unroll
                        for (int n = 0; n < 2; ++n) acc[a][b][m][n] = (f32x4){0.f, 0.f, 0.f, 0.f};
        }
        cur = nxt; cA = nA; cB = nB; ++ui; nxt = nn; has_next = has_nn;
        if constexpr (GATHER) { aoC[0][0] = aoN[0][0]; aoC[0][1] = aoN[0][1]; aoC[1][0] = aoN[1][0]; aoC[1][1] = aoN[1][1];
                                aoN[0][0] = aoNN[0][0]; aoN[0][1] = aoNN[0][1]; aoN[1][0] = aoNN[1][0]; aoN[1][1] = aoNN[1][1]; }
        if (wr == 1) PG8_BAR;
    }
    PG8_WAIT_V(0);
    PG8_BAR;
#undef PG8_SA
#undef PG8_SB
#undef PG8_STAGE
#undef PG8_LDA
#undef PG8_LDB
#undef PG8_MMA
#undef PG8_WAIT_V
#undef PG8_WAIT_L
#undef PG8_BAR
#undef PG8_SCHED
}
}
using pg8::Unit;

struct Frame {
    LAS unsigned char* lds;
    volatile LAS unsigned* MISC;
    gu32* ctl;
    int tid, lane, wave, vcu, G;
    unsigned char* ws; unsigned char* outb;
    const float* in[18];
};

__device__ __forceinline__ float wave_sum(float v) {
#pragma unroll
    for (int o = 1; o < 64; o <<= 1) v += __shfl_xor(v, o);
    return v;
}

struct CvtItem { const float* W; bf16* WT; const float* gain; int ldw, Kd; int f8; };
__device__ __forceinline__ void cvt_load(const CvtItem& it, int lane, f32x4 (&v)[8]) {
    const float* p = it.W + (size_t)(8 * (lane & 7)) * it.ldw + 4 * (lane >> 3);
#pragma unroll
    for (int i = 0; i < 8; ++i) v[i] = __builtin_nontemporal_load((const f32x4*)(p + (size_t)i * it.ldw));
}
__device__ __forceinline__ void cvt_store(const CvtItem& it, int lane, f32x4 (&v)[8]) {
    const int kc = lane & 7, ng = lane >> 3;
    if (it.gain) { const f32x4 g0 = *(const f32x4*)(it.gain + 8 * kc), g1 = *(const f32x4*)(it.gain + 8 * kc + 4);
#pragma unroll
        for (int i = 0; i < 4; ++i) { v[i] = v[i] * g0[i]; v[4 + i] = v[4 + i] * g1[i]; } }
    if (it.f8) {
        const bool odd = (kc & 1) != 0;
#pragma unroll
        for (int h = 0; h < 2; ++h) {
            u32x2 lo, hi;
            lo.x = pk4_fp8(v[0][h] * W8_SCALE, v[1][h] * W8_SCALE, v[2][h] * W8_SCALE, v[3][h] * W8_SCALE); lo.y = pk4_fp8(v[4][h] * W8_SCALE, v[5][h] * W8_SCALE, v[6][h] * W8_SCALE, v[7][h] * W8_SCALE);
            hi.x = pk4_fp8(v[0][2 + h] * W8_SCALE, v[1][2 + h] * W8_SCALE, v[2][2 + h] * W8_SCALE, v[3][2 + h] * W8_SCALE); hi.y = pk4_fp8(v[4][2 + h] * W8_SCALE, v[5][2 + h] * W8_SCALE, v[6][2 + h] * W8_SCALE, v[7][2 + h] * W8_SCALE);
            const unsigned gx = odd ? lo.x : hi.x, gy = odd ? lo.y : hi.y, kx = odd ? hi.x : lo.x, ky = odd ? hi.y : lo.y;
            const unsigned rx = (unsigned)__builtin_amdgcn_update_dpp(0, (int)gx, 0xB1, 0xF, 0xF, false), ry = (unsigned)__builtin_amdgcn_update_dpp(0, (int)gy, 0xB1, 0xF, 0xF, false);
            u32x4 w; w.x = odd ? rx : kx; w.y = odd ? ry : ky; w.z = odd ? kx : rx; w.w = odd ? ky : ry;
            __builtin_nontemporal_store(w, (u32x4*)((unsigned char*)it.WT + (size_t)(4 * ng + (odd ? 2 : 0) + h) * it.Kd + 8 * (kc & ~1))); }
        return; }
#pragma unroll
    for (int q = 0; q < 4; ++q) { u32x4 o; o.x = cvt_pk_bf16(v[0][q], v[1][q]); o.y = cvt_pk_bf16(v[2][q], v[3][q]); o.z = cvt_pk_bf16(v[4][q], v[5][q]); o.w = cvt_pk_bf16(v[6][q], v[7][q]);
        *(u32x4*)(it.WT + (size_t)(4 * ng + q) * it.Kd + 8 * kc) = o; }
}
constexpr int I_IN = 16 * 208, I_SQ = 16 * 32, I_G = 32 * 16 * 16, I_D = 32 * 8 * 32;
constexpr int N_CVT_ITEMS = I_IN + 3 * I_SQ + 2 * I_G + I_D;
constexpr int N_CVT_P0 = I_IN + 3 * I_SQ;
__device__ __forceinline__ CvtItem cvt_decode(const Frame& F, int r) {
    CvtItem c; c.gain = nullptr; c.f8 = 0;
    bf16* WIN = (bf16*)(F.ws + WS_WIN); unsigned char* WGU = F.ws + WS_WGU; unsigned char* WD = F.ws + WS_WD;
    if (r < I_IN) { const int kb = r / 208, nb = r % 208, n0 = 32 * nb; int dr = n0;
        if (n0 >= 1024 && n0 < 2048) { const int ch = n0 - 1024; dr = 1024 + 256 * (ch >> 7) + (ch & 127); }
        else if (n0 >= 2048 && n0 < 3072) { const int ch = n0 - 2048; dr = 1024 + 256 * (ch >> 7) + 128 + (ch & 127); }
        else if (n0 >= 4608 && n0 < 5632) { const int ch = n0 - 4608; dr = 4608 + 256 * (ch >> 7) + (ch & 127); }
        else if (n0 >= 5632) { const int ch = n0 - 5632; dr = 4608 + 256 * (ch >> 7) + 128 + (ch & 127); }
        c.W = F.in[2] + (size_t)(64 * kb) * NCOL + n0; c.ldw = NCOL; c.WT = WIN + (size_t)dr * D + 64 * kb; c.Kd = D; return c; }
    r -= I_IN;
    if (r < 3 * I_SQ) { const int w = r / I_SQ, q = r % I_SQ, kb = q / 32, nb = q % 32;
        const float* s0 = F.in[5]; const float* s1 = F.in[7]; const float* s2 = F.in[8];
        asm volatile("" : "+s"(s0)); asm volatile("" : "+s"(s1)); asm volatile("" : "+s"(s2));
        const float* src = (w == 0) ? s0 : (w == 1) ? s1 : s2;
        c.W = src + (size_t)(64 * kb) * D + 32 * nb; c.ldw = D; c.WT = (bf16*)(F.ws + WS_WA + (size_t)w * 2 * MiB) + (size_t)(32 * nb) * D + 64 * kb; c.Kd = D; return c; }
    r -= 3 * I_SQ;
    if (r < 2 * I_G) { const int up = r / I_G, rr = r % I_G, e = rr / 256, q = rr % 256, kb = q / 16, nb = q % 16, f0 = 32 * nb;
        const float* g0 = F.in[14]; const float* g1 = F.in[15]; asm volatile("" : "+s"(g0)); asm volatile("" : "+s"(g1));
        c.W = (up ? g1 : g0) + (size_t)e * D * FF + (size_t)(64 * kb) * FF + f0; c.ldw = FF;
        c.WT = (bf16*)(WGU + (size_t)e * D * D + (size_t)(256 * (f0 >> 7) + 128 * up + (f0 & 127)) * D + 64 * kb); c.Kd = D; c.gain = F.in[9] + 64 * kb; c.f8 = 1; return c; }
    r -= 2 * I_G;
    { const int e = r / 256, q = r % 256, kb = q / 32, nb = q % 32;
      c.W = F.in[16] + (size_t)e * FF * D + (size_t)(64 * kb) * D + 32 * nb; c.ldw = D; c.WT = (bf16*)(WD + (size_t)e * D * FF + (size_t)(32 * nb) * FF + 64 * kb); c.Kd = FF; c.f8 = 1; return c; }
}

__device__ __forceinline__ void p0_prologue(Frame& F) {
    const int gw = F.vcu * NWAVES + F.wave, NGW = F.G * NWAVES;
    { const float* x = F.in[0]; const float* g = F.in[1]; bf16* H = (bf16*)(F.ws + WS_H);
      f32x4 gv[4];
#pragma unroll
      for (int j = 0; j < 4; ++j) gv[j] = *((const GAS f32x4*)g + F.lane + 64 * j);
      for (int m = 4 * gw; m < M; m += 4 * NGW) {
        int mr[4]; f32x4 v[4][4]; float ss[4];
#pragma unroll
        for (int r = 0; r < 4; ++r) { mr[r] = m + r; const GAS f32x4* xa = (const GAS f32x4*)(x + (size_t)mr[r] * D) + F.lane;
#pragma unroll
            for (int j = 0; j < 4; ++j) v[r][j] = __builtin_nontemporal_load(xa + 64 * j); }
#pragma unroll
        for (int r = 0; r < 4; ++r) { float sa = 0.f;
#pragma unroll
            for (int j = 0; j < 4; ++j) sa += (v[r][j].x * v[r][j].x + v[r][j].y * v[r][j].y) + (v[r][j].z * v[r][j].z + v[r][j].w * v[r][j].w);
            ss[r] = sa; }
#pragma unroll
        for (int o = 1; o < 64; o <<= 1) {
#pragma unroll
            for (int r = 0; r < 4; ++r) ss[r] += __shfl_xor(ss[r], o); }
#pragma unroll
        for (int r = 0; r < 4; ++r) { const float rq = sqrtf(ss[r] * (1.f / D) + EPS), ra = 1.0f / rq; GAS u32x2* oa = (GAS u32x2*)(H + (size_t)mr[r] * D) + F.lane;
            if (F.lane == 0) ((float*)(F.ws + WS_RI))[mr[r]] = rq;
#pragma unroll
            for (int j = 0; j < 4; ++j) { u32x2 w; w.x = cvt_pk_bf16(v[r][j].x * ra * gv[j].x, v[r][j].y * ra * gv[j].y); w.y = cvt_pk_bf16(v[r][j].z * ra * gv[j].z, v[r][j].w * ra * gv[j].w); oa[64 * j] = w; } }
      } }
    for (int it = gw; it < N_CVT_P0; it += 2 * NGW) {
        const int it2 = (it + NGW < N_CVT_P0) ? it + NGW : it;
        const CvtItem ca = cvt_decode(F, it), cb = cvt_decode(F, it2);
        f32x4 va[8], vb[8];
        cvt_load(ca, F.lane, va); cvt_load(cb, F.lane, vb);
        cvt_store(ca, F.lane, va); cvt_store(cb, F.lane, vb);
    }
    { const float* wg = F.in[10]; const float* we = F.in[12]; const float* g_ffn = F.in[9]; u32x4* RWF = (u32x4*)(F.ws + WS_RWF);
      const int gt = F.vcu * (NWAVES * 64) + F.tid, NGT = F.G * NWAVES * 64;
      for (int idx = gt; idx < 32 * 3 * 64; idx += NGT) {
        const int l = idx & 63, st = idx >> 6, t = st % 3, s = st / 3, col = 16 * t + (l & 15), k0 = 32 * s + 8 * (l >> 4);
        unsigned hi[8], lo[8];
#pragma unroll
        for (int j = 0; j < 8; ++j) { const int k = k0 + j; float w = 0.f;
            if (col < 4) w = wg[k * 4 + col]; else if (col < 36) w = we[k * 32 + col - 4];
            w *= g_ffn[k]; const unsigned h = f2bf(w); hi[j] = h; lo[j] = f2bf(w - bf2f((unsigned short)h)); }
        u32x4 vh, vl; vh.x = hi[0] | (hi[1] << 16); vh.y = hi[2] | (hi[3] << 16); vh.z = hi[4] | (hi[5] << 16); vh.w = hi[6] | (hi[7] << 16);
        vl.x = lo[0] | (lo[1] << 16); vl.y = lo[2] | (lo[3] << 16); vl.z = lo[4] | (lo[5] << 16); vl.w = lo[6] | (lo[7] << 16);
        RWF[((size_t)st * 2 + 0) * 64 + l] = vh; RWF[((size_t)st * 2 + 1) * 64 + l] = vl; } }
}

constexpr size_t TSTEP1024 = (size_t)256 * 1024 * 2;
struct SchedPlain {
    const char* A; const char* Bt; int nM, nN, G, c; size_t tstep;
    __device__ __forceinline__ bool next(int i, Unit& u) const { u.x0 = 0; u.x1 = i; u.x2 = 0; return pg8::static_unit((long)i * G + c, nM, nN, u.pm, u.pn); }
    __device__ __forceinline__ const char* a_base(const Unit& u) const { return A + (size_t)u.pm * tstep; }
    __device__ __forceinline__ const char* b_base(const Unit& u) const { return Bt + (size_t)u.pn * tstep; }
    __device__ __forceinline__ void rows(const Unit&, const int*, const int*, unsigned (&)[2][2]) const {}
};
struct SchedG1 {
    const char* A; const char* Bt; int c;
    __device__ __forceinline__ bool next(int i, Unit& u) const { u.x0 = 0; u.x1 = i; u.x2 = 0; if (i >= 13) return false;
        if (i < 3) { int sx; pg8::static_unit((long)i * 256 + c, M / 256, 6, u.pm, sx); u.pn = 12 + sx; }
        else if (i < 9) { const int j = (i - 3) / 3, part = (i - 3) % 3; int ti; pg8::static_unit((long)j * 256 + c, M / 256, 4, u.pm, ti); u.pn = (part < 2) ? 4 + 2 * ti + part : ti; }
        else { int sx; pg8::static_unit((long)(i - 9) * 256 + c, M / 256, 8, u.pm, sx); u.pn = 18 + sx; }
        return true; }
    __device__ __forceinline__ const char* a_base(const Unit& u) const { return A + (size_t)u.pm * TSTEP1024; }
    __device__ __forceinline__ const char* b_base(const Unit& u) const { return Bt + (size_t)u.pn * TSTEP1024; }
    __device__ __forceinline__ void rows(const Unit&, const int*, const int*, unsigned (&)[2][2]) const {}
};
struct SchedDual {
    const char* A0; long dA; const char* B0; long dB; int nM, nN, G, c;
    __device__ __forceinline__ bool next(int i, Unit& u) const { u.x0 = i & 1; u.x1 = 0; u.x2 = 0; return pg8::static_unit((long)(i >> 1) * G + c, nM, nN, u.pm, u.pn); }
    __device__ __forceinline__ const char* a_base(const Unit& u) const { return A0 + ((-(long)u.x0) & dA) + (size_t)u.pm * TSTEP1024; }
    __device__ __forceinline__ const char* b_base(const Unit& u) const { return B0 + ((-(long)u.x0) & dB) + (size_t)u.pn * TSTEP1024; }
    __device__ __forceinline__ void rows(const Unit&, const int*, const int*, unsigned (&)[2][2]) const {}
};
struct SchedMoE {
    const char* A; const char* Bt; const LAS int* pfx; const int* ltok; int G, c; int K; size_t a_tstep, b_estep, b_tstep; bool gather;
    __device__ __forceinline__ bool next(int i, Unit& u) const {
        const int nM = pfx[32];
        if (!pg8::static_unit((long)i * G + c, nM, 4, u.pm, u.pn)) return false;
        const int e = __builtin_amdgcn_readfirstlane(pfx[T2E_OFF_WORDS + u.pm]);
        const int mt = u.pm - pfx[e];
        u.x0 = e; u.x1 = pfx[40 + e] - 256 * mt; u.x2 = e * CAP + 256 * mt; return true;
    }
    __device__ __forceinline__ const char* a_base(const Unit& u) const { return gather ? A : A + (size_t)u.pm * a_tstep; }
    __device__ __forceinline__ const char* b_base(const Unit& u) const { return Bt + (size_t)u.x0 * b_estep + (size_t)u.pn * b_tstep; }
    __device__ __forceinline__ void rows(const Unit& u, const int* Rl, const int* Cb, unsigned (&off)[2][2]) const {
#pragma unroll
        for (int h = 0; h < 2; ++h)
#pragma unroll
            for (int i = 0; i < 2; ++i) { const int rl = h * 128 + Rl[i]; const int tok = ltok[u.x2 + (rl < u.x1 ? rl : 0)] >> 1;
                off[h][i] = (unsigned)tok * (unsigned)K + (unsigned)Cb[i]; }
    }
};

struct EpiG1 {
    bf16 *Bo  , *CUo, *Qo, *Ko, *Vo, *GAo, *GBo, *B2o; const Frame* F; int G, c; XcdBarrier sb; bool split;
    __device__ __forceinline__ bool keep(const Unit&) const { return false; }
    __device__ __forceinline__ void operator()(f32x4 (&acc)[2][2][4][2], const Unit& u, int wr, int wc, int fr, int fq) const {
        const int sidx = N_CVT_P0 + (u.x1 * G + c) * NWAVES + (wr * 4 + wc); const bool side = sidx < N_CVT_ITEMS;
        CvtItem sc; f32x4 sv[8];
        if (side) { sc = cvt_decode(*F, sidx); cvt_load(sc, fr + 16 * fq, sv); }
        if (u.pn < 4) { if (side) cvt_store(sc, fr + 16 * fq, sv); body(acc, u, wr, wc, fr, fq); return; }
        body(acc, u, wr, wc, fr, fq);
        if (side) cvt_store(sc, fr + 16 * fq, sv);
        if (split && u.x1 == 2) { asm volatile("s_waitcnt vmcnt(0)" ::: "memory"); xcd_split_arrive(sb, 0); }
    }
    __device__ __forceinline__ void conv_tile(f32x4 (&acc)[2][2][4][2], const Unit& u, int wr, int wc, int fr_, int fq_) const {
        int fr = fr_, fq = fq_; asm volatile("" : "+v"(fr), "+v"(fq));
        const LAS float* cwl = (const LAS float*)(F->lds + CONVW_OFF);
        const int lane = fr + 16 * fq, src1 = (lane & ~15) | ((fr - 1) & 15), src2 = (lane & ~15) | ((fr - 2) & 15);
#pragma unroll
        for (int bj = 0; bj < 2; ++bj) {
            const int ch0 = 256 * u.pn + 128 * bj + 32 * wc + 8 * fq;
            float w0[8], w1[8], w2[8], cbv[8];
#pragma unroll
            for (int q = 0; q < 2; ++q) { const f32x4 a0 = *(const LAS f32x4*)(cwl + ch0 + 4 * q), a1 = *(const LAS f32x4*)(cwl + D + ch0 + 4 * q), a2 = *(const LAS f32x4*)(cwl + 2 * D + ch0 + 4 * q), a3 = *(const LAS f32x4*)(cwl + 3 * D + ch0 + 4 * q);
#pragma unroll
                for (int e = 0; e < 4; ++e) { w0[4 * q + e] = a0[e]; w1[4 * q + e] = a1[e]; w2[4 * q + e] = a2[e]; cbv[4 * q + e] = a3[e]; } }
#pragma unroll
            for (int ai = 0; ai < 2; ++ai) {
                asm volatile("" ::: "memory");
                const int t0 = u.pm * 256 + ai * 128 + wr * 64;
                u32x4 cur[5];
#pragma unroll
                for (int m = 0; m < 5; ++m) { int row = t0 - 16 + 16 * m + fr; row = row < 0 ? 0 : row;
                    cur[m] = *(const u32x4*)((const char*)CUo + (unsigned)(row * D + ch0) * 2u); }
#pragma unroll
                for (int m = 0; m < 4; ++m) {
                    const u32x4 c = cur[m + 1], pv = cur[m]; u32x4 t1, t2;
#pragma unroll
                    for (int e = 0; e < 4; ++e) {
                        const unsigned c1 = (unsigned)__builtin_amdgcn_update_dpp(0, (int)c[e], 0x121, 0xF, 0xF, false), p1 = (unsigned)__builtin_amdgcn_update_dpp(0, (int)pv[e], 0x121, 0xF, 0xF, false);
                        const unsigned c2 = (unsigned)__builtin_amdgcn_update_dpp(0, (int)c[e], 0x122, 0xF, 0xF, false), p2 = (unsigned)__builtin_amdgcn_update_dpp(0, (int)pv[e], 0x122, 0xF, 0xF, false);
                        t1[e] = (fr >= 1) ? c1 : p1; t2[e] = (fr >= 2) ? c2 : p2; }
                    float fc[8], f1[8], f2[8], y[8]; unpack8(c, fc); unpack8(t1, f1); unpack8(t2, f2);
#pragma unroll
                    for (int n = 0; n < 2; ++n)
#pragma unroll
                        for (int q = 0; q < 4; ++q) { const int k = 4 * n + q; y[k] = acc[ai][bj][m][n][q] * (w0[k] * f2[k] + w1[k] * f1[k] + w2[k] * fc[k] + cbv[k]); }
                    u32x4 w; w.x = cvt_pk_bf16(y[0], y[1]); w.y = cvt_pk_bf16(y[2], y[3]); w.z = cvt_pk_bf16(y[4], y[5]); w.w = cvt_pk_bf16(y[6], y[7]);
                    *(u32x4*)((char*)Bo + (unsigned)((t0 + 16 * m + fr) * D + ch0) * 2u) = w;
                    if (ai == 0 && m == 0 && wr == 0 && fr < 2) {
                        u32x4 wb; wb.x = cvt_pk_bf16(acc[0][bj][0][0][0], acc[0][bj][0][0][1]); wb.y = cvt_pk_bf16(acc[0][bj][0][0][2], acc[0][bj][0][0][3]);
                        wb.z = cvt_pk_bf16(acc[0][bj][0][1][0], acc[0][bj][0][1][1]); wb.w = cvt_pk_bf16(acc[0][bj][0][1][2], acc[0][bj][0][1][3]);
                        *(u32x4*)((char*)B2o + (unsigned)((u.pm * 2 + fr) * D + ch0) * 2u) = wb; }
                } } }
    }
    __device__ __forceinline__ void body(f32x4 (&acc)[2][2][4][2], const Unit& u, int wr, int wc, int fr, int fq) const {
        const int row0 = u.pm * 256 + wr * 64 + fr, pn = u.pn, cb = wc * 32 + 8 * fq;
        if (pn >= 4 && pn < 12) {
#pragma unroll
            for (int ai = 0; ai < 2; ++ai)
#pragma unroll
                for (int m = 0; m < 4; ++m) { bf16* rowp = CUo + (size_t)(row0 + ai * 128 + m * 16) * D + 128 * (pn - 4) + cb;
                    const f32x4 v0 = acc[ai][0][m][0] * acc[ai][1][m][0], v1 = acc[ai][0][m][1] * acc[ai][1][m][1];
                    u32x4 w; w.x = cvt_pk_bf16(v0[0], v0[1]); w.y = cvt_pk_bf16(v0[2], v0[3]); w.z = cvt_pk_bf16(v1[0], v1[1]); w.w = cvt_pk_bf16(v1[2], v1[3]);
                    *(u32x4*)rowp = w; }
            return;
        }
        if (pn < 4) { conv_tile(acc, u, wr, wc, fr, fq); return; }
        bf16* base; int ldc = D, col = cb; int mode = 0; float sc = 1.f;
        if (pn < 16) { base = Qo; col += 256 * (pn - 12); sc = QSCALE; }
        else if (pn == 16) { base = Ko; ldc = KVW; }
        else if (pn == 17) { base = Vo; ldc = KVW; }
        else { base = GAo; col += 128 * (pn - 18); mode = 2; }
#pragma unroll
        for (int ai = 0; ai < 2; ++ai)
#pragma unroll
            for (int m = 0; m < 4; ++m) { bf16* rowp = base + (size_t)(row0 + ai * 128 + m * 16) * ldc + col;
                if (mode == 2) {
                    float ra[8], sbv[8];
#pragma unroll
                    for (int n = 0; n < 2; ++n)
#pragma unroll
                        for (int q = 0; q < 4; ++q) { const float ea = __builtin_amdgcn_exp2f(-LOG2E * acc[ai][0][m][n][q]), eb = __builtin_amdgcn_exp2f(-LOG2E * acc[ai][1][m][n][q]);
                            const float sb = __builtin_amdgcn_rcpf(1.0f + eb); sbv[4 * n + q] = sb; ra[4 * n + q] = __builtin_amdgcn_rcpf((1.0f + ea) * fmaxf(sb, 1e-30f)); }
                    u32x4 w; w.x = cvt_pk_bf16(ra[0], ra[1]); w.y = cvt_pk_bf16(ra[2], ra[3]); w.z = cvt_pk_bf16(ra[4], ra[5]); w.w = cvt_pk_bf16(ra[6], ra[7]); __builtin_nontemporal_store(w, (u32x4*)rowp);
                    u32x4 v; v.x = cvt_pk_bf16(sbv[0], sbv[1]); v.y = cvt_pk_bf16(sbv[2], sbv[3]); v.z = cvt_pk_bf16(sbv[4], sbv[5]); v.w = cvt_pk_bf16(sbv[6], sbv[7]);
                    __builtin_nontemporal_store(v, (u32x4*)(GBo + (size_t)(row0 + ai * 128 + m * 16) * D + col));
                } else {
#pragma unroll
                    for (int bj = 0; bj < 2; ++bj) { const f32x4 v0 = acc[ai][bj][m][0] * sc, v1 = acc[ai][bj][m][1] * sc;
                        u32x4 w; w.x = cvt_pk_bf16(v0[0], v0[1]); w.y = cvt_pk_bf16(v0[2], v0[3]); w.z = cvt_pk_bf16(v1[0], v1[1]); w.w = cvt_pk_bf16(v1[2], v1[3]);
                        *(u32x4*)(rowp + bj * 128) = w; } } }
    }
};
struct EpiG3 {
    const bf16* GA; const bf16* GB; bf16* MO;
    __device__ __forceinline__ bool keep(const Unit& u) const { return u.x0 == 0; }
    __device__ __forceinline__ void operator()(f32x4 (&acc)[2][2][4][2], const Unit& u, int wr, int wc, int fr, int fq) const {
        const int row0 = u.pm * 256 + wr * 64 + fr, col0 = u.pn * 256 + wc * 32 + 8 * fq;
        const unsigned off0 = (unsigned)(row0 * D + col0) * 2u;
        if (u.x0 == 0) {
#pragma unroll
            for (int ai = 0; ai < 2; ++ai) {
                u32x4 ga[4][2];
#pragma unroll
                for (int m = 0; m < 4; ++m)
#pragma unroll
                    for (int bj = 0; bj < 2; ++bj) ga[m][bj] = *(const u32x4*)((const char*)GA + off0 + (unsigned)((ai * 128 + m * 16) * D + bj * 128) * 2u);
#pragma unroll
                for (int m = 0; m < 4; ++m)
#pragma unroll
                    for (int bj = 0; bj < 2; ++bj) { float a[8]; unpack8(ga[m][bj], a);
#pragma unroll
                        for (int q = 0; q < 4; ++q) { acc[ai][bj][m][0][q] *= a[q]; acc[ai][bj][m][1][q] *= a[4 + q]; } } }
        } else {
#pragma unroll
            for (int ai = 0; ai < 2; ++ai) {
                u32x4 gb[4][2];
#pragma unroll
                for (int m = 0; m < 4; ++m)
#pragma unroll
                    for (int bj = 0; bj < 2; ++bj) gb[m][bj] = *(const u32x4*)((const char*)GB + off0 + (unsigned)((ai * 128 + m * 16) * D + bj * 128) * 2u);
#pragma unroll
                for (int m = 0; m < 4; ++m)
#pragma unroll
                    for (int bj = 0; bj < 2; ++bj) { float b[8]; unpack8(gb[m][bj], b);
                        f32x4 v0 = acc[ai][bj][m][0], v1 = acc[ai][bj][m][1];
#pragma unroll
                        for (int q = 0; q < 4; ++q) { v0[q] *= fmaxf(b[q], 1e-30f); v1[q] *= fmaxf(b[4 + q], 1e-30f); }
                        u32x4 w; w.x = cvt_pk_bf16(v0[0], v0[1]); w.y = cvt_pk_bf16(v0[2], v0[3]); w.z = cvt_pk_bf16(v1[0], v1[1]); w.w = cvt_pk_bf16(v1[2], v1[3]);
                        *(u32x4*)((char*)MO + off0 + (unsigned)((ai * 128 + m * 16) * D + bj * 128) * 2u) = w; } }
        }
    }
};
struct EpiG4 {
    const bf16* Hn; const float* RI; const float* gmix; bf16* X1;
    __device__ __forceinline__ bool keep(const Unit&) const { return false; }
    __device__ __forceinline__ void operator()(f32x4 (&acc)[2][2][4][2], const Unit& u, int wr, int wc, int fr, int fq) const {
        const int row0 = u.pm * 256 + wr * 64 + fr, col0 = u.pn * 256 + wc * 32 + 8 * fq;
        float gi[2][8];
#pragma unroll
        for (int bj = 0; bj < 2; ++bj) { const f32x4 g0 = *(const f32x4*)(gmix + col0 + bj * 128), g1 = *(const f32x4*)(gmix + col0 + bj * 128 + 4);
#pragma unroll
            for (int q = 0; q < 4; ++q) { gi[bj][q] = __builtin_amdgcn_rcpf(g0[q]); gi[bj][4 + q] = __builtin_amdgcn_rcpf(g1[q]); } }
#pragma unroll
        for (int ai = 0; ai < 2; ++ai) {
            u32x4 hv[4][2]; float ri[4];
#pragma unroll
            for (int m = 0; m < 4; ++m) { const int row = row0 + ai * 128 + m * 16; ri[m] = RI[row];
#pragma unroll
                for (int bj = 0; bj < 2; ++bj) hv[m][bj] = *(const u32x4*)(Hn + (size_t)row * D + col0 + bj * 128); }
#pragma unroll
            for (int m = 0; m < 4; ++m)
#pragma unroll
                for (int bj = 0; bj < 2; ++bj) { float hx[8]; unpack8(hv[m][bj], hx); f32x4 v0 = acc[ai][bj][m][0], v1 = acc[ai][bj][m][1];
#pragma unroll
                    for (int q = 0; q < 4; ++q) { v0[q] += hx[q] * ri[m] * gi[bj][q]; v1[q] += hx[4 + q] * ri[m] * gi[bj][4 + q]; }
                    u32x4 w; w.x = cvt_pk_bf16(v0[0], v0[1]); w.y = cvt_pk_bf16(v0[2], v0[3]); w.z = cvt_pk_bf16(v1[0], v1[1]); w.w = cvt_pk_bf16(v1[2], v1[3]);
                    *(u32x4*)(X1 + (size_t)(row0 + ai * 128 + m * 16) * D + col0 + bj * 128) = w; } }
    }
};
struct EpiG6 {
    const f32x2* LRW; bf16* ACT;
    __device__ __forceinline__ bool keep(const Unit&) const { return false; }
    __device__ __forceinline__ void operator()(f32x4 (&acc)[2][2][4][2], const Unit& u, int wr, int wc, int fr, int fq) const {
        const int rl0 = wr * 64 + fr, col0 = u.pn * 128 + wc * 32 + 8 * fq;
        f32x2 rw[2][4];
#pragma unroll
        for (int ai = 0; ai < 2; ++ai)
#pragma unroll
            for (int m = 0; m < 4; ++m) { const int rl = rl0 + ai * 128 + m * 16; rw[ai][m] = LRW[u.x2 + (rl < u.x1 ? rl : 0)]; }
#pragma unroll
        for (int ai = 0; ai < 2; ++ai)
#pragma unroll
            for (int m = 0; m < 4; ++m) { const int rl = rl0 + ai * 128 + m * 16; const bool ok = rl < u.x1; const float rs = ok ? rw[ai][m].x : 0.f, wsv = ok ? rw[ai][m].y : 0.f;
                float o[8];
#pragma unroll
                for (int n = 0; n < 2; ++n)
#pragma unroll
                    for (int q = 0; q < 4; ++q) { const float g = acc[ai][0][m][n][q] * rs, up = acc[ai][1][m][n][q] * rs; o[4 * n + q] = wsv * g * fast_sigmoid(g) * up; }
                u32x2 w; w.x = pk4_fp8(o[0] * A8_SCALE, o[1] * A8_SCALE, o[2] * A8_SCALE, o[3] * A8_SCALE); w.y = pk4_fp8(o[4] * A8_SCALE, o[5] * A8_SCALE, o[6] * A8_SCALE, o[7] * A8_SCALE);
                *(u32x2*)((unsigned char*)ACT + (size_t)(u.pm * 256 + rl) * FF + col0) = w; }
    }
};
struct EpiG7 {
    unsigned char* PS;
    __device__ __forceinline__ bool keep(const Unit&) const { return false; }
    __device__ __forceinline__ void operator()(f32x4 (&acc)[2][2][4][2], const Unit& u, int wr, int wc, int fr, int fq) const {
        const int odd = fq & 1, lane = fr + 16 * fq, partner = (lane ^ 16) * 4;
        const unsigned off0 = (unsigned)((u.pm * 256 + wr * 64 + fr) * D + u.pn * 256 + wc * 32 + 16 * (fq >> 1) + 128 * odd);
#pragma unroll
        for (int ai = 0; ai < 2; ++ai)
#pragma unroll
            for (int m = 0; m < 4; ++m) { u32x2 w[2];
#pragma unroll
                for (int bj = 0; bj < 2; ++bj) { const f32x4 v0 = acc[ai][bj][m][0] * P8_SCALE, v1 = acc[ai][bj][m][1] * P8_SCALE;
                    w[bj].x = pk4_fp8(v0[0], v0[1], v0[2], v0[3]); w[bj].y = pk4_fp8(v1[0], v1[1], v1[2], v1[3]); }
                const u32x2 give = odd ? w[0] : w[1], keepv = odd ? w[1] : w[0];
                u32x2 got; got.x = (unsigned)__builtin_amdgcn_ds_bpermute(partner, (int)give.x); got.y = (unsigned)__builtin_amdgcn_ds_bpermute(partner, (int)give.y);
                u32x4 o; if (odd) { o.x = got.x; o.y = got.y; o.z = keepv.x; o.w = keepv.y; } else { o.x = keepv.x; o.y = keepv.y; o.z = got.x; o.w = got.y; }
                *(u32x4*)(PS + off0 + (unsigned)((ai * 128 + m * 16) * D)) = o; }
    }
};

constexpr int ATT_BUF = 65536, ATT_V_OFF = 32768;
__device__ __forceinline__ s16x4 vtr(const LAS unsigned char* p) { return __builtin_bit_cast(s16x4, __builtin_amdgcn_ds_read_tr16_b64_v4i16((LAS s16x4*)p)); }

__device__ __forceinline__ void attn_issue(Frame& F, int u, int bsel, const bf16* Kg, const bf16* Vg, const bf16* zeros) {
    const int kh = u & 3, n = (u >> 2) & 63, b = u >> 8, T0 = b * SEQ + n * 128, lane = F.lane;
    LAS unsigned char* base = F.lds + bsel * ATT_BUF;
#pragma unroll
    for (int j = 0; j < 4; ++j) { const int q = F.wave * 4 + j, row = 8 * q + (lane >> 3), cp = lane & 7; const bool ok = (n > 0) || (row >= 128);
        const long tok = (long)T0 - 128 + row;
        const bf16* ks = ok ? Kg + tok * KVW + kh * 64 + ((cp ^ ((row >> 1) & 7)) * 8) : zeros + lane * 8;
        const bf16* vs = ok ? Vg + tok * KVW + kh * 64 + ((cp ^ (((row >> 1) & 1) << 2)) * 8) : zeros + lane * 8;
        __builtin_amdgcn_global_load_lds((const unsigned*)ks, (LAS unsigned*)(base + q * 1024), 16, 0, 0);
        __builtin_amdgcn_global_load_lds((const unsigned*)vs, (LAS unsigned*)(base + ATT_V_OFF + q * 1024), 16, 0, 0); }
}

__device__ __forceinline__ void conv_fixup(Frame& F, const bf16* B2, const bf16* CUg, bf16* YC, const float* cw, const float* cbias) {
    if (F.wave != 0) return;
    for (int item = F.vcu; item < (M / 256) * 2; item += F.G) {
        const int pm = item >> 1, r = item & 1, t = pm * 256 + r, tseq = t & (SEQ - 1);
#pragma unroll 1
        for (int half = 0; half < 2; ++half) { const int c0 = half * 512 + F.lane * 8;
            float w0[8], w1[8], w2[8], cb[8], fc[8], f1[8], f2[8], bv[8], y[8];
#pragma unroll
            for (int q = 0; q < 8; ++q) { w0[q] = cw[c0 + q]; w1[q] = cw[D + c0 + q]; w2[q] = cw[2 * D + c0 + q]; cb[q] = cbias[c0 + q]; f1[q] = 0.f; f2[q] = 0.f; }
            unpack8(*(const u32x4*)(CUg + (size_t)t * D + c0), fc); unpack8(*(const u32x4*)(B2 + (size_t)(pm * 2 + r) * D + c0), bv);
            if (tseq >= 1) unpack8(*(const u32x4*)(CUg + (size_t)(t - 1) * D + c0), f1);
            if (tseq >= 2) unpack8(*(const u32x4*)(CUg + (size_t)(t - 2) * D + c0), f2);
#pragma unroll
            for (int q = 0; q < 8; ++q) y[q] = bv[q] * (w0[q] * f2[q] + w1[q] * f1[q] + w2[q] * fc[q] + cb[q]);
            u32x4 w; w.x = cvt_pk_bf16(y[0], y[1]); w.y = cvt_pk_bf16(y[2], y[3]); w.z = cvt_pk_bf16(y[4], y[5]); w.w = cvt_pk_bf16(y[6], y[7]);
            *(u32x4*)(YC + (size_t)t * D + c0) = w; }
    }
}
__device__ __forceinline__ void attn_phase(Frame& F, bf16* QO, const bf16* Kg, const bf16* Vg, const float* sinks, const bf16* Bg, const bf16* CUg, bf16* YC, const float* cw, const float* cbias, bool fuse_conv) {
    const int lane = F.lane, wid = F.wave, r32 = lane & 31, hi = lane >> 5;
    const bf16* zeros = (const bf16*)(F.ws + WS_CTL + 48 * 1024);
    const int NU = BATCH * (SEQ / 128) * NKV;
    const int c0 = (wid & 1) * 512 + lane * 8; const int ctok0 = F.vcu * 128 + (wid >> 1) * 32;
    LAS float* cwl = (LAS float*)(F.lds + CONVW_OFF);
    u32x4 pr1 = (u32x4){0u, 0u, 0u, 0u}, pr2 = pr1;
    if (fuse_conv) {
        for (int i = F.tid; i < 4 * D; i += NWAVES * 64) cwl[i] = (i < 3 * D) ? cw[i] : cbias[i - 3 * D];
        if ((ctok0 & (SEQ - 1)) != 0) { pr1 = *(const u32x4*)(CUg + (size_t)(ctok0 - 1) * D + c0); pr2 = *(const u32x4*)(CUg + (size_t)(ctok0 - 2) * D + c0); }
    }
    int slot = 0;
    int u = F.vcu;
    bf16x8 qf[4];
    if (u < NU) { attn_issue(F, u, 0, Kg, Vg, zeros);
        const int kh = u & 3, n = (u >> 2) & 63, b = u >> 8; const unsigned qo = (unsigned)(((b * SEQ + n * 128) + 32 * (2 * (wid & 1)) + r32) * D + (kh * 4 + (wid >> 1)) * 64 + 8 * hi) * 2u;
#pragma unroll
        for (int ks = 0; ks < 4; ++ks) qf[ks] = *(const bf16x8*)((const char*)QO + qo + 32 * ks); }
    for (int it = 0; u < NU; u += F.G, ++it) {
        const int kh = u & 3, n = (u >> 2) & 63, b = u >> 8;
        const int T0 = b * SEQ + n * 128;
        const int g = wid >> 1, head = kh * 4 + g;
        const float slope2 = __builtin_amdgcn_exp2f(-0.5f * (float)(head + 1)) * LOG2E;
        const float sink2 = sinks[head] * LOG2E;
        asm volatile("s_waitcnt vmcnt(0)" ::: "memory");
        __syncthreads();
        const bool more = (u + F.G < NU);
        if (more) attn_issue(F, u + F.G, (it + 1) & 1, Kg, Vg, zeros);
        const LAS unsigned char* Kl = F.lds + (it & 1) * ATT_BUF; const LAS unsigned char* Vl = Kl + ATT_V_OFF;
        const int kswz = (r32 >> 1) & 7;
#pragma unroll 1
        for (int p = 0; p < 2; ++p) {
            const int qs = 2 * (wid & 1) + p;
            const unsigned qoff = (unsigned)((T0 + 32 * qs + r32) * D + head * 64 + 4 * hi) * 2u;
            bf16x8 qn[4];
            { const int un = (p == 0) ? u : u + F.G; const int khn = un & 3, nn = (un >> 2) & 63, bn = un >> 8;
              const unsigned qno = (unsigned)(((bn * SEQ + nn * 128) + 32 * (2 * (wid & 1) + (p ^ 1)) + r32) * D + (khn * 4 + g) * 64 + 8 * hi) * 2u;
              if (p == 0 || more) {
#pragma unroll
                  for (int ks = 0; ks < 4; ++ks) qn[ks] = *(const bf16x8*)((const char*)QO + qno + 32 * ks); }
              else {
#pragma unroll
                  for (int ks = 0; ks < 4; ++ks) qn[ks] = qf[ks]; } }
            u32x4 cva[4], cvb[4];
            if (fuse_conv) {
#pragma unroll
                for (int t = 0; t < 4; ++t) { const unsigned off = (unsigned)((ctok0 + 4 * slot + t) * D + c0) * 2u; cva[t] = *(const u32x4*)((const char*)CUg + off); cvb[t] = *(const u32x4*)((const char*)Bg + off); } }
            f32x16 s[5];
#pragma unroll
            for (int ti = 0; ti < 5; ++ti) { const LAS unsigned char* kb = Kl + (32 * (qs + ti) + r32) * 128;
                f32x16 a = {};
#pragma unroll
                for (int ks = 0; ks < 4; ++ks) { const bf16x8 kf = *(const LAS bf16x8*)(kb + (((2 * ks + hi) ^ kswz) * 16)); a = __builtin_amdgcn_mfma_f32_32x32x16_bf16(kf, qf[ks], a, 0, 0, 0); }
                s[ti] = a; }
            float sl = slope2; int rl = 4 * hi - r32; asm volatile("" : "+v"(sl), "+v"(rl));
            const float base = sl * (float)(rl - 128);
            float mx = -INFINITY;
#pragma unroll
            for (int ti = 0; ti < 5; ++ti) { const bool dead = (n == 0) && (qs + ti < 4);
#pragma unroll
                for (int r = 0; r < 16; ++r) { const int ro = (r & 3) + 8 * (r >> 2); float v = s[ti][r] + (sl * (float)(32 * ti + ro) + base);
                    const int rel0 = ro + rl;
                    bool ok = !dead;
                    if (ti == 0) ok = ok && (rel0 >= 1);
                    if (ti == 4) ok = ok && (rel0 <= 0);
                    v = ok ? v : -INFINITY; s[ti][r] = v; mx = fmaxf(mx, v); } }
            mx = fmaxf(mx, __shfl_xor(mx, 32)); mx = fmaxf(mx, sink2);
            float sum = 0.f;
#pragma unroll
            for (int ti = 0; ti < 5; ++ti)
#pragma unroll
                for (int r = 0; r < 16; ++r) { const float e = __builtin_amdgcn_exp2f(s[ti][r] - mx); s[ti][r] = e; sum += e; }
            sum += __shfl_xor(sum, 32);
            const float inv = 1.0f / (sum + __builtin_amdgcn_exp2f(sink2 - mx));
            f32x16 o[2]; o[0] = (f32x16){}; o[1] = (f32x16){};
            const int i16 = lane & 15, gsel = (lane >> 4) & 1;
            const int vcol = (gsel * 16 + 4 * (i16 & 3)) * 2;
            const int vswz = ((i16 >> 3) & 1) << 6;
#pragma unroll
            for (int ti = 0; ti < 5; ++ti)
#pragma unroll
                for (int s2 = 0; s2 < 2; ++s2) {
                    u32x4 pw; pw.x = cvt_pk_bf16(s[ti][8 * s2 + 0], s[ti][8 * s2 + 1]); pw.y = cvt_pk_bf16(s[ti][8 * s2 + 2], s[ti][8 * s2 + 3]);
                    pw.z = cvt_pk_bf16(s[ti][8 * s2 + 4], s[ti][8 * s2 + 5]); pw.w = cvt_pk_bf16(s[ti][8 * s2 + 6], s[ti][8 * s2 + 7]);
                    const bf16x8 pf = __builtin_bit_cast(bf16x8, pw);
                    const int key0 = 32 * (qs + ti) + 16 * s2 + 4 * hi + (i16 >> 2);
#pragma unroll
                    for (int dt = 0; dt < 2; ++dt) {
                        const LAS unsigned char* vp = Vl + key0 * 128 + ((dt * 64 + vcol) ^ vswz);
                        const s16x4 lo = vtr(vp), hh = vtr(vp + 8 * 128);
                        const bf16x8 vf = (bf16x8){lo[0], lo[1], lo[2], lo[3], hh[0], hh[1], hh[2], hh[3]};
                        o[dt] = __builtin_amdgcn_mfma_f32_32x32x16_bf16(vf, pf, o[dt], 0, 0, 0); } }
#pragma unroll
            for (int dt = 0; dt < 2; ++dt)
#pragma unroll
                for (int rq = 0; rq < 4; ++rq) { u32x2 w; w.x = cvt_pk_bf16(o[dt][4 * rq] * inv, o[dt][4 * rq + 1] * inv); w.y = cvt_pk_bf16(o[dt][4 * rq + 2] * inv, o[dt][4 * rq + 3] * inv);
                    *(u32x2*)((char*)QO + qoff + (32 * dt + 8 * rq) * 2) = w; }
            if (fuse_conv) {
                float w0[8], w1[8], w2[8], cb[8];
#pragma unroll
                for (int q = 0; q < 2; ++q) { const f32x4 a0 = *(const LAS f32x4*)(cwl + c0 + 4 * q), a1 = *(const LAS f32x4*)(cwl + D + c0 + 4 * q), a2 = *(const LAS f32x4*)(cwl + 2 * D + c0 + 4 * q), a3 = *(const LAS f32x4*)(cwl + 3 * D + c0 + 4 * q);
#pragma unroll
                    for (int e = 0; e < 4; ++e) { w0[4 * q + e] = a0[e]; w1[4 * q + e] = a1[e]; w2[4 * q + e] = a2[e]; cb[4 * q + e] = a3[e]; } }
#pragma unroll
                for (int t = 0; t < 4; ++t) { float cu[8], bv[8], y[8], p1[8], p2[8]; unpack8(cva[t], cu); unpack8(cvb[t], bv); unpack8(pr1, p1); unpack8(pr2, p2);
#pragma unroll
                    for (int q = 0; q < 8; ++q) y[q] = bv[q] * (w0[q] * p2[q] + w1[q] * p1[q] + w2[q] * cu[q] + cb[q]);
                    pr2 = pr1; pr1 = cva[t];
                    u32x4 w; w.x = cvt_pk_bf16(y[0], y[1]); w.y = cvt_pk_bf16(y[2], y[3]); w.z = cvt_pk_bf16(y[4], y[5]); w.w = cvt_pk_bf16(y[6], y[7]);
                    *(u32x4*)((char*)YC + (unsigned)((ctok0 + 4 * slot + t) * D + c0) * 2u) = w; }
                ++slot; }
#pragma unroll
            for (int ks = 0; ks < 4; ++ks) qf[ks] = qn[ks];
        }
    }
    asm volatile("s_waitcnt vmcnt(0)" ::: "memory");
    __syncthreads();
}

__device__ __forceinline__ void conv_phase(Frame& F, const bf16* Bg, const bf16* CUg, bf16* YC, const float* cw, const float* cbias) {
    const int gw = F.vcu * NWAVES + F.wave, NGW = F.G * NWAVES;
    for (int it = gw; it < (M / 32) * 2; it += NGW) {
        const int half = it & 1, t0 = (it >> 1) * 32, c0 = half * 512 + F.lane * 8;
        float w0[8], w1[8], w2[8], cb[8], p1[8], p2[8];
#pragma unroll
        for (int q = 0; q < 8; ++q) { w0[q] = cw[c0 + q]; w1[q] = cw[D + c0 + q]; w2[q] = cw[2 * D + c0 + q]; cb[q] = cbias[c0 + q]; p1[q] = 0.f; p2[q] = 0.f; }
        if ((t0 & (SEQ - 1)) != 0) {
            const u32x4 a = *(const u32x4*)(CUg + (size_t)(t0 - 1) * D + c0), c = *(const u32x4*)(CUg + (size_t)(t0 - 2) * D + c0);
            p1[0] = bflo(a.x); p1[1] = bfhi(a.x); p1[2] = bflo(a.y); p1[3] = bfhi(a.y); p1[4] = bflo(a.z); p1[5] = bfhi(a.z); p1[6] = bflo(a.w); p1[7] = bfhi(a.w);
            p2[0] = bflo(c.x); p2[1] = bfhi(c.x); p2[2] = bflo(c.y); p2[3] = bfhi(c.y); p2[4] = bflo(c.z); p2[5] = bfhi(c.z); p2[6] = bflo(c.w); p2[7] = bfhi(c.w);
        }
#pragma unroll 4
        for (int t = 0; t < 32; ++t) {
            const u32x4 a = *(const u32x4*)(CUg + (size_t)(t0 + t) * D + c0), bb = *(const u32x4*)(Bg + (size_t)(t0 + t) * D + c0);
            const float cu[8] = {bflo(a.x), bfhi(a.x), bflo(a.y), bfhi(a.y), bflo(a.z), bfhi(a.z), bflo(a.w), bfhi(a.w)};
            const float bv[8] = {bflo(bb.x), bfhi(bb.x), bflo(bb.y), bfhi(bb.y), bflo(bb.z), bfhi(bb.z), bflo(bb.w), bfhi(bb.w)};
            float y[8];
#pragma unroll
            for (int q = 0; q < 8; ++q) { y[q] = bv[q] * (w0[q] * p2[q] + w1[q] * p1[q] + w2[q] * cu[q] + cb[q]); p2[q] = p1[q]; p1[q] = cu[q]; }
            u32x4 w; w.x = pk2(y[0], y[1]); w.y = pk2(y[2], y[3]); w.z = pk2(y[4], y[5]); w.w = pk2(y[6], y[7]);
            *(u32x4*)(YC + (size_t)(t0 + t) * D + c0) = w;
        }
    }
}

__device__ __forceinline__ void router_phase(Frame& F, const bf16* X1, bf16* X1B) {
    const int lane = F.lane, wid = F.wave, tid = F.tid;
    LAS float* lg = (LAS float*)(F.lds + wid * 3072);
    LAS int* lcnt = (LAS int*)(F.lds + 24576); LAS int* lbase = lcnt + 32;
    LAS u32x4* RWL = (LAS u32x4*)(F.lds + 32768);
    { const u32x4* RWF = (const u32x4*)(F.ws + WS_RWF);
      for (int i = tid; i < 96 * 64; i += NWAVES * 64) RWL[i] = RWF[(size_t)(i >> 6) * 128 + (i & 63)]; }
    __syncthreads();
    const float* bg = F.in[11]; const float* be = F.in[13];
    int* LT = (int*)(F.ws + WS_LTOK); f32x2* LRW = (f32x2*)(F.ws + WS_LR);
    for (int tb = F.vcu; tb < M / 128; tb += F.G) {
        if (tid < 32) lcnt[tid] = 0;
        __syncthreads();
        const int tok0 = tb * 128 + wid * 16, row = lane & 15, kg = lane >> 4;
        const bf16* xr = X1 + (size_t)(tok0 + row) * D + 8 * kg;
        f32x4 acc[3]; acc[0] = (f32x4){0.f, 0.f, 0.f, 0.f}; acc[1] = acc[0]; acc[2] = acc[0];
        float ss = 0.f;
        const int rot = (8 * wid + 8 * tb + 3 * (tb >> 2)) & 31;
#define RT_LOAD(XA, c4) do { _Pragma("unroll") for (int q = 0; q < 4; ++q) { const int s_ = (4 * (c4) + q + rot) & 31; XA[q] = *(const u32x4*)(xr + 32 * s_); } } while (0)
#define RT_COMP(XA, c4) do { _Pragma("unroll") for (int q = 0; q < 4; ++q) { const int s = (4 * (c4) + q + rot) & 31; \
            float xv[8]; unpack8(XA[q], xv);                             \
            _Pragma("unroll") for (int j = 0; j < 8; ++j) ss += xv[j] * xv[j]; \
            { u32x2 w8; w8.x = pk4_fp8(xv[0], xv[1], xv[2], xv[3]); w8.y = pk4_fp8(xv[4], xv[5], xv[6], xv[7]); *(u32x2*)((unsigned char*)X1B + (size_t)(tok0 + row) * D + 8 * kg + 32 * s) = w8; } \
            const bf16x8 Ah = __builtin_bit_cast(bf16x8, XA[q]); \
            _Pragma("unroll") for (int t = 0; t < 3; ++t) { \
                const bf16x8 Bh = __builtin_bit_cast(bf16x8, RWL[(s * 3 + t) * 64 + lane]); \
                acc[t] = __builtin_amdgcn_mfma_f32_16x16x32_bf16(Ah, Bh, acc[t], 0, 0, 0); } } } while (0)
        { u32x4 xa0[4], xa1[4];
          RT_LOAD(xa0, 0);
#pragma unroll 1
          for (int c4 = 0; c4 < 8; c4 += 2) {
              RT_LOAD(xa1, c4 + 1);
              RT_COMP(xa0, c4);
              if (c4 + 2 < 8) RT_LOAD(xa0, c4 + 2);
              RT_COMP(xa1, c4 + 1);
          } }
#undef RT_LOAD
#undef RT_COMP
#pragma unroll
        for (int t = 0; t < 3; ++t)
#pragma unroll
            for (int i = 0; i < 4; ++i) lg[(4 * kg + i) * 48 + 16 * t + row] = acc[t][i];
        ss += __shfl_xor(ss, 16); ss += __shfl_xor(ss, 32);
        const float rr = 1.0f / sqrtf(ss * (1.f / D) + EPS);
        LDS_WAIT(); asm volatile("" ::: "memory");
        int e0 = 0, e1 = 0, rank0 = 0, rank1 = 0; float w0 = 0.f, w1 = 0.f;
        if (lane < 16) {
            const LAS float* my = lg + lane * 48;
            float gl[4];
#pragma unroll
            for (int j = 0; j < 4; ++j) gl[j] = rr * my[j] + bg[j];
            int gi = 0; float gm = gl[0];
#pragma unroll
            for (int j = 1; j < 4; ++j) if (gl[j] > gm) { gm = gl[j]; gi = j; }
            float den = 0.f;
#pragma unroll
            for (int j = 0; j < 4; ++j) den += __expf(gl[j] - gm);
            const float pg = 1.0f / den;
            float v0 = -INFINITY, v1 = -INFINITY; int i0 = 0, i1 = 0;
#pragma unroll
            for (int i = 0; i < 8; ++i) { const float v = rr * my[4 + 8 * gi + i] + be[8 * gi + i];
                if (v > v0) { v1 = v0; i1 = i0; v0 = v; i0 = i; } else if (v > v1) { v1 = v; i1 = i; } }
            const float ex = __expf(v1 - v0), s0 = 1.0f / (1.0f + ex);
            w0 = pg * s0; w1 = pg * (ex * s0);
            e0 = 8 * gi + i0; e1 = 8 * gi + i1;
            rank0 = __hip_atomic_fetch_add(lcnt + e0, 1, __ATOMIC_RELAXED, __HIP_MEMORY_SCOPE_WORKGROUP); rank1 = __hip_atomic_fetch_add(lcnt + e1, 1, __ATOMIC_RELAXED, __HIP_MEMORY_SCOPE_WORKGROUP);
        }
        __syncthreads();
        if (tid < 32) { const int c = lcnt[tid]; int bs = 0; if (c > 0) bs = (int)__hip_atomic_fetch_add((unsigned*)(F.ctl + CW_CNT + 64 * tid), (unsigned)c, RLX_AGENT); lbase[tid] = bs; }
        __syncthreads();
        if (lane < 16) { const int tok = tok0 + lane;
            const int p0 = e0 * CAP + lbase[e0] + rank0, p1 = e1 * CAP + lbase[e1] + rank1;
            LT[p0] = tok * 2; LRW[p0] = (f32x2){rr, w0};
            LT[p1] = tok * 2 + 1; LRW[p1] = (f32x2){rr, w1};
            *(int2*)((int*)(F.ws + WS_POS) + 2 * tok) = make_int2(p0, p1); }
        __syncthreads();
    }
}

__device__ __forceinline__ void final_phase(Frame& F, const bf16* X1, const unsigned char* PAIRS, const float* g, float* OUT, const int* POS, const LAS int* pfx) {
    const int gw = F.vcu * NWAVES + F.wave, NGW = F.G * NWAVES;
    float gf[2][8];
#pragma unroll
    for (int j = 0; j < 2; ++j)
#pragma unroll
        for (int q = 0; q < 8; ++q) gf[j][q] = g[512 * j + 8 * F.lane + q];
    int2 pnx = *(const int2*)(POS + 2 * (gw < M ? gw : 0));
    for (int m = gw; m < M; m += NGW) {
        const int2 pc = pnx; { const int mn = (m + NGW < M) ? m + NGW : m; pnx = *(const int2*)(POS + 2 * mn); }
        const int q0 = __builtin_amdgcn_readfirstlane(pc.x), q1 = __builtin_amdgcn_readfirstlane(pc.y);
        const size_t r0 = (size_t)(256 * pfx[q0 >> 15] + (q0 & (CAP - 1))), r1 = (size_t)(256 * pfx[q1 >> 15] + (q1 & (CAP - 1)));
        u32x4 hv[2]; u32x2 pa[2], pb[2];
#pragma unroll
        for (int j = 0; j < 2; ++j) { const unsigned c = 512 * j + 8 * F.lane;
            hv[j] = *(const u32x4*)(X1 + (size_t)m * D + c);
            pa[j] = *(const u32x2*)(PAIRS + r0 * D + c); pb[j] = *(const u32x2*)(PAIRS + r1 * D + c); }
        float v[2][8]; float s = 0.f;
#pragma unroll
        for (int j = 0; j < 2; ++j) { float hx[8]; unpack8(hv[j], hx);
            const f32x2 a0 = __builtin_amdgcn_cvt_pk_f32_fp8((int)pa[j].x, false), a1 = __builtin_amdgcn_cvt_pk_f32_fp8((int)pa[j].x, true), a2 = __builtin_amdgcn_cvt_pk_f32_fp8((int)pa[j].y, false), a3 = __builtin_amdgcn_cvt_pk_f32_fp8((int)pa[j].y, true);
            const f32x2 b0 = __builtin_amdgcn_cvt_pk_f32_fp8((int)pb[j].x, false), b1 = __builtin_amdgcn_cvt_pk_f32_fp8((int)pb[j].x, true), b2 = __builtin_amdgcn_cvt_pk_f32_fp8((int)pb[j].y, false), b3 = __builtin_amdgcn_cvt_pk_f32_fp8((int)pb[j].y, true);
            const float pp[8] = {a0.x + b0.x, a0.y + b0.y, a1.x + b1.x, a1.y + b1.y, a2.x + b2.x, a2.y + b2.y, a3.x + b3.x, a3.y + b3.y};
#pragma unroll
            for (int q = 0; q < 8; ++q) { const float x = hx[q] + pp[q] * (1.0f / P8_SCALE); v[j][q] = x; s += x * x; } }
        const float rs = 1.0f / sqrtf(wave_sum(s) * (1.f / D) + EPS);
#pragma unroll
        for (int j = 0; j < 2; ++j) { float* o = OUT + (size_t)m * D + 512 * j + 8 * F.lane;
            __builtin_nontemporal_store((f32x4){v[j][0] * rs * gf[j][0], v[j][1] * rs * gf[j][1], v[j][2] * rs * gf[j][2], v[j][3] * rs * gf[j][3]}, (f32x4*)o);
            __builtin_nontemporal_store((f32x4){v[j][4] * rs * gf[j][4], v[j][5] * rs * gf[j][5], v[j][6] * rs * gf[j][6], v[j][7] * rs * gf[j][7]}, (f32x4*)(o + 4)); }
    }
}

struct Args { const float* in[18]; float* out; unsigned char* ws; int ph_lo, ph_hi; };
__global__ void __launch_bounds__(NWAVES * 64, 2) mk_fwd(Args args) {
    extern __shared__ __attribute__((aligned(16))) unsigned char lds[];
    Frame F;
    F.lds = (LAS unsigned char*)lds;
    F.MISC = (volatile LAS unsigned*)(F.lds + MISC_OFF);
    F.tid = threadIdx.x; F.lane = F.tid & 63; F.wave = __builtin_amdgcn_readfirstlane(F.tid >> 6);
    F.G = gridDim.x; { const int bx = blockIdx.x; F.vcu = (F.G % 8 == 0) ? (bx % 8) * (F.G / 8) + bx / 8 : bx; }
    F.ws = args.ws; F.outb = (unsigned char*)args.out; F.ctl = (gu32*)(args.ws + WS_CTL);
#pragma unroll
    for (int i = 0; i < 18; ++i) F.in[i] = args.in[i];
    for (int u = F.tid; u < 1024 / 4; u += NWAVES * 64) ((LAS unsigned*)(F.lds + LDSCTL_OFF))[u] = 0u;
    __syncthreads();
    XcdBarrier bar; bar.bar = (unsigned*)(F.ctl + CW_BAR); bar.x = 0; bar.st = nullptr;
    if (N_LAUNCHES == 1) bar = xcd_barrier_post((unsigned*)(F.ctl + CW_BAR), F.MISC + 8);
    const int lo = args.ph_lo, hi = args.ph_hi;
#define IN(k) (lo <= (k) && (k) < hi)
#define BOTH(k) (IN(k) && IN((k) + 1))
#define GRID_BAR() xcd_barrier(bar)
    unsigned long long tprev = 0, span = 0;
    if (PROBE_K >= 0) tprev = __builtin_amdgcn_s_memrealtime();
#define STAMP(k) do { if (PROBE_K >= 0) { const unsigned long long now_ = __builtin_amdgcn_s_memrealtime(); if (PROBE_K == (k)) span = now_ - tprev; tprev = now_; } } while (0)

    bf16* H = (bf16*)(F.ws + WS_H); bf16* Bb = (bf16*)(F.ws + WS_B); bf16* CUb = (bf16*)(F.ws + WS_CU);
    bf16* Kb = (bf16*)(F.ws + WS_K); bf16* Vb = (bf16*)(F.ws + WS_V); bf16* GBb = (bf16*)(F.ws + WS_GB);
    bf16* QO = (bf16*)F.outb; bf16* GAb = (bf16*)(F.outb + 64 * MiB);
    bf16* X1B = (bf16*)(F.ws + WS_X1B); unsigned char* ACT8 = F.ws + WS_ACT; const float* RI = (const float*)(F.ws + WS_RI);
    const LAS int* pfx = (const LAS int*)(F.lds + PFX_OFF);

    if (IN(0)) { p0_prologue(F);
        if (BOTH(0)) { if (USE_CG_SYNC) { VM_WAIT(); cg::this_grid().sync(); }
            else { GRID_BAR();
                   if (__builtin_amdgcn_readfirstlane((int)xb_ld(bar.bar + XB_TMO)) != 0) { VM_WAIT(); cg::this_grid().sync(); } } } }
    STAMP(0);

    if (IN(1)) {
        { LAS float* cwl = (LAS float*)(F.lds + CONVW_OFF); const float* cw = F.in[3]; const float* cbias = F.in[4];
          for (int i = F.tid; i < 4 * D; i += NWAVES * 64) cwl[i] = (i < 3 * D) ? cw[i] : cbias[i - 3 * D]; }
        __syncthreads();
        SchedG1 S{(const char*)H, (const char*)(F.ws + WS_WIN), (int)blockIdx.x};
        EpiG1 E{Bb, CUb, QO, Kb, Vb, GAb, GBb, (bf16*)(F.ws + WS_B2), &F, F.G, (int)blockIdx.x, bar, BOTH(1)};
        pg8::gemm_phase<EpiG1, SchedG1, false>(F.lds, D, S, E);
        if (BOTH(1)) { xcd_split_arrive(bar, 1);
                       xcd_split_wait(bar, 0); }
    }
    STAMP(1);
    if (IN(2)) {
        const bool fuse_conv = false;
        attn_phase(F, QO, Kb, Vb, F.in[6], Bb, CUb, H, F.in[3], F.in[4], fuse_conv);
        if (BOTH(1)) xcd_split_wait(bar, 1);
        conv_fixup(F, (const bf16*)(F.ws + WS_B2), CUb, Bb, F.in[3], F.in[4]);
        STAMP(2);
        if (BOTH(2)) GRID_BAR();
    }
    STAMP(3);
    if (IN(3)) {
        SchedDual S{(const char*)Bb, (long)((const char*)QO - (const char*)Bb), (const char*)(F.ws + WS_WA), (long)(WS_WB - WS_WA), M / 256, D / 256, F.G, (int)blockIdx.x};
        EpiG3 E{GAb, GBb, CUb};
        pg8::gemm_phase<EpiG3, SchedDual, false>(F.lds, D, S, E);
        if (BOTH(3)) GRID_BAR();
    }
    STAMP(4);
    if (IN(4)) {
        SchedPlain S{(const char*)CUb, (const char*)(F.ws + WS_WO), M / 256, D / 256, F.G, (int)blockIdx.x, TSTEP1024};
        EpiG4 E{H, RI, F.in[1], Bb};
        pg8::gemm_phase<EpiG4, SchedPlain, false>(F.lds, D, S, E);
        if (BOTH(4)) GRID_BAR();
    }
    STAMP(5);
    if (IN(5)) { router_phase(F, Bb, X1B); if (BOTH(5)) GRID_BAR(); }
    STAMP(6);
    if (IN(6) || IN(7)) {
        if (F.tid == 0) { LAS int* p = (LAS int*)(F.lds + PFX_OFF); int run = 0;
            for (int e = 0; e < NEXP; ++e) { const int c = (int)__hip_atomic_load((unsigned*)(F.ctl + CW_CNT + 64 * e), RLX_AGENT); p[e] = run; p[40 + e] = c;
                const int nt = (c + 255) >> 8; for (int t = 0; t < nt; ++t) p[T2E_OFF_WORDS + run + t] = e; run += nt; }
            p[32] = run; }
        __syncthreads();
    }
    if (IN(6)) {
        SchedMoE S{(const char*)X1B, (const char*)(F.ws + WS_WGU), pfx, (const int*)(F.ws + WS_LTOK), F.G, (int)blockIdx.x, D  , 0, (size_t)D * D, (size_t)256 * D, true};
        EpiG6 E{(const f32x2*)(F.ws + WS_LR), (bf16*)ACT8};
        pg8::gemm_phase<EpiG6, SchedMoE, true, true>(F.lds, D, S, E, 127, W8_E8M0);
        if (BOTH(6)) GRID_BAR();
    }
    STAMP(7);
    if (IN(7)) {
        SchedMoE S{(const char*)ACT8, (const char*)(F.ws + WS_WD), pfx, (const int*)(F.ws + WS_LTOK), F.G, (int)blockIdx.x, FF, (size_t)256 * FF, (size_t)D * FF, (size_t)256 * FF, false};
        EpiG7 E{(unsigned char*)GBb};
        pg8::gemm_phase<EpiG7, SchedMoE, false, true>(F.lds, FF, S, E, A8_E8M0, W8_E8M0);
        if (BOTH(7)) GRID_BAR();
    }
    STAMP(8);
    if (IN(8)) {
        if (N_LAUNCHES != 1) {
            if (F.tid == 0) { LAS int* p = (LAS int*)(F.lds + PFX_OFF); int run = 0;
                for (int e = 0; e < NEXP; ++e) { const int c = (int)__hip_atomic_load((unsigned*)(F.ctl + CW_CNT + 64 * e), RLX_AGENT); p[e] = run; p[40 + e] = c; run += (c + 255) >> 8; }
                p[32] = run; }
            __syncthreads(); }
        final_phase(F, Bb, (const unsigned char*)GBb, F.in[17], (float*)F.outb, (const int*)(F.ws + WS_POS), pfx);
    }
    STAMP(9);
    if (PROBE_K >= 0) { const unsigned long long tgt = __builtin_amdgcn_s_memrealtime() + PROBE_MULT * span; while (__builtin_amdgcn_s_memrealtime() < tgt) __builtin_amdgcn_s_sleep(16); }
#undef IN
#undef BOTH
#undef GRID_BAR
}

extern "C" void kernel_launch(void* const* d_in, const int* in_sizes, int n_in, void* d_out, int out_size, void* d_ws, size_t ws_size, hipStream_t stream) {
    static int grid = 0;
    if (grid == 0) {
        if (n_in != 18 || in_sizes[0] != M * D || out_size != M * D || ws_size < WS_END) { fprintf(stderr, "kernel_launch: unexpected shapes (n_in %d, ws %zu)\n", n_in, ws_size); grid = -1; return; }
        int dev = 0, cus = 0, per_cu = 0;
        if (hipGetDevice(&dev) != hipSuccess || hipDeviceGetAttribute(&cus, hipDeviceAttributeMultiprocessorCount, dev) != hipSuccess) { grid = -1; return; }
        if (hipFuncSetAttribute((const void*)mk_fwd, hipFuncAttributeMaxDynamicSharedMemorySize, LDS_BYTES) != hipSuccess) { fprintf(stderr, "kernel_launch: hipFuncSetAttribute failed\n"); grid = -1; return; }
        if (hipOccupancyMaxActiveBlocksPerMultiprocessor(&per_cu, (const void*)mk_fwd, NWAVES * 64, LDS_BYTES) != hipSuccess || per_cu < 1) { fprintf(stderr, "kernel_launch: occupancy query says %d\n", per_cu); (void)hipGetLastError(); grid = -1; return; }
        if (per_cu > 1) per_cu = 1;
        grid = cus * per_cu;
        if (grid != 256) { fprintf(stderr, "kernel_launch: this build's P1 unit order needs a grid of exactly 256 workgroups (one per CU of a 256-CU device); got %d\n", grid); grid = -1; return; }
    }
    if (grid < 0) return;
    (void)hipMemsetAsync((char*)d_ws + WS_CTL, 0, CTL_ZERO_BYTES, stream);
    Args a{};
    for (int i = 0; i < 18; ++i) a.in[i] = (const float*)d_in[i];
    a.out = (float*)d_out; a.ws = (unsigned char*)d_ws;
    if (N_LAUNCHES == 1) {
        a.ph_lo = 0; a.ph_hi = N_PHASES;
        void* kargs[] = {&a};
        hipError_t e = hipLaunchCooperativeKernel((const void*)mk_fwd, dim3(grid), dim3(NWAVES * 64), kargs, LDS_BYTES, stream);
        if (e != hipSuccess) fprintf(stderr, "kernel_launch: cooperative launch failed: %s (grid %d)\n", hipGetErrorString(e), grid);
    } else {
        for (int li = 0; li < N_PHASES; ++li) { a.ph_lo = li; a.ph_hi = li + 1;
            hipLaunchKernelGGL(mk_fwd, dim3(grid), dim3(NWAVES * 64), LDS_BYTES, stream, a); }
    }
}
```

```cpp
#include <hip/hip_runtime.h>
#include <hip/hip_cooperative_groups.h>
#include <cstdio>
#include <cstdint>
namespace cg = cooperative_groups;

#ifndef MK_N_LAUNCHES
#define MK_N_LAUNCHES 1
#endif
constexpr int N_LAUNCHES = MK_N_LAUNCHES;
#ifndef PROBE_K
#define PROBE_K -1
#endif
#define PROBE_MULT 4
#ifndef USE_CG_SYNC
#define USE_CG_SYNC 0
#endif
constexpr int N_PHASES = 9;

#define GAS __attribute__((address_space(1)))
#define LAS __attribute__((address_space(3)))
typedef unsigned short bf16;
typedef short bf16x8 __attribute__((ext_vector_type(8)));
typedef short s16x4 __attribute__((ext_vector_type(4)));
typedef float f32x4 __attribute__((ext_vector_type(4)));
typedef float f32x2 __attribute__((ext_vector_type(2)));
typedef float f32x16 __attribute__((ext_vector_type(16)));
typedef unsigned u32x4 __attribute__((ext_vector_type(4)));
typedef unsigned u32x2 __attribute__((ext_vector_type(2)));
typedef GAS unsigned gu32;
typedef int i32x4 __attribute__((ext_vector_type(4)));
typedef int i32x8 __attribute__((ext_vector_type(8)));

constexpr int D = 1024, BATCH = 4, SEQ = 8192, M = BATCH * SEQ;
constexpr int NCOL = 6656, NHEAD = 16, HD = 64, NKV = 4, KVW = 256;
constexpr int NEXP = 32, NGRP = 4, EPG = 8, FF = 512, CAP = 32768;
constexpr float EPS = 1e-6f;
constexpr float LOG2E = 1.4426950408889634f;
constexpr float QSCALE = 0.125f * LOG2E;
constexpr int NWAVES = 8;

constexpr size_t MiB = 1u << 20;
constexpr size_t WS_CTL = 0, CTL_ZERO_BYTES = 80 * 1024;
constexpr size_t WS_RWF = 1 * MiB;
constexpr size_t WS_WIN = 2 * MiB;
constexpr size_t WS_WA = 15 * MiB, WS_WB = 17 * MiB, WS_WO = 19 * MiB;
constexpr size_t WS_WGU = 21 * MiB;
constexpr size_t WS_WD = 85 * MiB;
constexpr size_t WS_LTOK = 117 * MiB, WS_LR = 121 * MiB, WS_LW = 125 * MiB;
constexpr size_t WS_H = 129 * MiB;
constexpr size_t WS_B = 193 * MiB;
constexpr size_t WS_CU = 257 * MiB;
constexpr size_t WS_K = 321 * MiB, WS_V = 337 * MiB;
constexpr size_t WS_GB = 353 * MiB;
constexpr size_t WS_PAIRS = 321 * MiB;
constexpr size_t WS_B2 = 449 * MiB;
constexpr size_t WS_RI = 450 * MiB;
constexpr size_t WS_X1B = 257 * MiB;
constexpr size_t WS_ACT = 289 * MiB;
constexpr size_t WS_POS = 450 * MiB + 256 * 1024;
constexpr size_t WS_END = 451 * MiB;

constexpr int CW_TMO = 0;
constexpr int CW_CNT = 64;
constexpr int CW_BAR = 4096;

constexpr int RING_BYTES = 131072;
constexpr int LDSCTL_OFF = RING_BYTES, MISC_OFF = LDSCTL_OFF + 320, PFX_OFF = LDSCTL_OFF + 512;
constexpr int CONVW_OFF = LDSCTL_OFF + 1024;
constexpr int T2E_OFF_WORDS = (CONVW_OFF - PFX_OFF) / 4;
constexpr int LDS_BYTES = 163840;

#define RLX_AGENT __ATOMIC_RELAXED, __HIP_MEMORY_SCOPE_AGENT
#define LDS_WAIT() asm volatile("s_waitcnt lgkmcnt(0)" ::: "memory")
#define VM_WAIT() asm volatile("s_waitcnt vmcnt(0)" ::: "memory")
__device__ __forceinline__ unsigned f2bf(float f) { unsigned u = __builtin_bit_cast(unsigned, f); return (u + 0x7fffu + ((u >> 16) & 1u)) >> 16; }
__device__ __forceinline__ unsigned pk2(float lo, float hi) { return f2bf(lo) | (f2bf(hi) << 16); }
__device__ __forceinline__ float bf2f(unsigned short b) { return __builtin_bit_cast(float, (unsigned)b << 16); }
__device__ __forceinline__ float bflo(unsigned w) { return __builtin_bit_cast(float, w << 16); }
__device__ __forceinline__ float bfhi(unsigned w) { return __builtin_bit_cast(float, w & 0xffff0000u); }
__device__ __forceinline__ unsigned cvt_pk_bf16(float lo, float hi) { unsigned r; asm volatile("v_cvt_pk_bf16_f32 %0, %1, %2" : "=v"(r) : "v"(lo), "v"(hi)); return r; }
__device__ __forceinline__ void unpack8(const u32x4& a, float (&f)[8]) { f[0] = bflo(a.x); f[1] = bfhi(a.x); f[2] = bflo(a.y); f[3] = bfhi(a.y); f[4] = bflo(a.z); f[5] = bfhi(a.z); f[6] = bflo(a.w); f[7] = bfhi(a.w); }
__device__ __forceinline__ unsigned pk4_fp8(float a, float b, float c, float d) {
    a = __builtin_amdgcn_fmed3f(a, -448.f, 448.f); b = __builtin_amdgcn_fmed3f(b, -448.f, 448.f); c = __builtin_amdgcn_fmed3f(c, -448.f, 448.f); d = __builtin_amdgcn_fmed3f(d, -448.f, 448.f);
    int w = 0; w = __builtin_amdgcn_cvt_pk_fp8_f32(a, b, w, false); w = __builtin_amdgcn_cvt_pk_fp8_f32(c, d, w, true); return (unsigned)w; }
constexpr float W8_SCALE = 32.f;  constexpr int W8_E8M0 = 127 - 5;
constexpr float A8_SCALE = 16.f;  constexpr int A8_E8M0 = 127 - 4;
constexpr float P8_SCALE = 16.f;
__device__ __forceinline__ float fast_sigmoid(float x) { return __builtin_amdgcn_rcpf(1.0f + __builtin_amdgcn_exp2f(-LOG2E * x)); }

#define XB_TMO      128
#define XB_XCNT(j)  (256  + 64 * (j))
#define XB_XSUB(j)  (1280 + 64 * (j))
#define XB_XGEN(j)  (2304 + 64 * (j))
#define XB_TOP      3328
#define XB_TOPGEN   3392
#define XCD_BAR_WORDS 3456
#define XB_SPIN_CAP (1u << 18)
__device__ __forceinline__ unsigned xb_ld(unsigned* p)              { return __hip_atomic_load(p, __ATOMIC_RELAXED, __HIP_MEMORY_SCOPE_AGENT); }
__device__ __forceinline__ unsigned xb_add(unsigned* p, unsigned v) { return __hip_atomic_fetch_add(p, v, __ATOMIC_RELAXED, __HIP_MEMORY_SCOPE_AGENT); }
__device__ __forceinline__ unsigned xb_xcc_id() { return (unsigned)__builtin_amdgcn_s_getreg((3 << 11) | 20) & 0xFu; }
#define XB_SPIN(cond, bar) do { unsigned _sp = 0; while (cond) { __builtin_amdgcn_s_sleep(1); \
    if ((++_sp & 255u) == 0u) { if (xb_ld(&(bar)[XB_TMO])) break; if (_sp > XB_SPIN_CAP) { atomicAdd(&(bar)[XB_TMO], 1u); break; } } } } while (0)
struct XcdBarrier { unsigned* bar; unsigned x; volatile LAS unsigned* st; };
__device__ __forceinline__ XcdBarrier xcd_barrier_post(unsigned* bar, volatile LAS unsigned* st) {
    XcdBarrier b; b.bar = bar; b.x = xb_xcc_id(); b.st = st;
    if (threadIdx.x == 0) (void)xb_add(&bar[XB_XCNT(b.x)], 1u);
    return b;
}
__device__ __forceinline__ void xcd_barrier_complete(unsigned* bar, unsigned x, unsigned& nloc, unsigned& nx) {
    const unsigned G = gridDim.x * gridDim.y * gridDim.z;
    unsigned sum, cnt, mine, sp = 0u;
    for (;;) {
        sum = 0u; cnt = 0u; mine = 0u;
#pragma unroll
        for (unsigned j = 0; j < 16; ++j) { const unsigned c = xb_ld(&bar[XB_XCNT(j)]); sum += c; cnt += (c > 0u) ? 1u : 0u; mine = (j == x) ? c : mine; }
        if (sum == G) break;
        __builtin_amdgcn_s_sleep(1);
        if ((++sp & 255u) == 0u) { if (xb_ld(&bar[XB_TMO])) break; if (sp > XB_SPIN_CAP) { atomicAdd(&bar[XB_TMO], 1u); break; } }
    }
    nloc = mine > 0u ? mine : 1u; nx = cnt > 0u ? cnt : 1u;
}
__device__ __forceinline__ void xcd_barrier(const XcdBarrier& b) {
    asm volatile("s_waitcnt vmcnt(0)" ::: "memory");
    __syncthreads();
    if (threadIdx.x == 0) {
        unsigned* bar = b.bar;
        __builtin_amdgcn_s_waitcnt(0);
        unsigned nloc = b.st[0], nx = b.st[1];
        if (nloc == 0u) { xcd_barrier_complete(bar, b.x, nloc, nx); b.st[0] = nloc; b.st[1] = nx; }
        const unsigned old = xb_add(&bar[XB_XSUB(b.x)], 1u);
        const unsigned gen = old / nloc;
        if (old + 1u == (gen + 1u) * nloc) {
            __builtin_amdgcn_fence(__ATOMIC_RELEASE, "agent");
            asm volatile("s_waitcnt vmcnt(0)" ::: "memory");
            const unsigned og = xb_add(&bar[XB_TOP], 1u);
            const unsigned tg = og / nx;
            if (og + 1u == (tg + 1u) * nx) xb_add(&bar[XB_TOPGEN], 1u);
            else XB_SPIN(xb_ld(&bar[XB_TOPGEN]) == tg, bar);
            __builtin_amdgcn_fence(__ATOMIC_ACQUIRE, "agent");
            xb_add(&bar[XB_XGEN(b.x)], 1u);
            asm volatile("s_waitcnt vmcnt(0)" ::: "memory");
        } else {
            XB_SPIN(xb_ld(&bar[XB_XGEN(b.x)]) == gen, bar);
            __builtin_amdgcn_fence(__ATOMIC_ACQUIRE, "agent");
            asm volatile("s_waitcnt vmcnt(0)" ::: "memory");
        }
    }
    __syncthreads();
}

#define XS_BASE(s)    ((s) < 4 ? XCD_BAR_WORDS + (s) * 1152 : 9216 + ((s) - 4) * 1152)
#define XS_XSUB(s, j) (XS_BASE(s) + 64 * (j))
#define XS_TOP(s)     (XS_BASE(s) + 1024)
#define XS_GEN(s)     (XS_BASE(s) + 1088)
__device__ __forceinline__ void xcd_split_arrive(const XcdBarrier& b, int s) {
    __syncthreads();
    if (threadIdx.x == 0) {
        unsigned* bar = b.bar;
        const unsigned nloc = b.st[0], nx = b.st[1];
        const unsigned old = xb_add(&bar[XS_XSUB(s, b.x)], 1u);
        if (old + 1u == nloc) {
            __builtin_amdgcn_fence(__ATOMIC_RELEASE, "agent");
            asm volatile("s_waitcnt vmcnt(0)" ::: "memory");
            const unsigned og = xb_add(&bar[XS_TOP(s)], 1u);
            if (og + 1u == nx) xb_add(&bar[XS_GEN(s)], 1u);
        }
    }
}
__device__ __forceinline__ void xcd_split_wait(const XcdBarrier& b, int s) {
    if (threadIdx.x == 0) {
        XB_SPIN(xb_ld(&b.bar[XS_GEN(s)]) == 0u, b.bar);
        __builtin_amdgcn_fence(__ATOMIC_ACQUIRE, "agent");
        asm volatile("s_waitcnt vmcnt(0)" ::: "memory");
    }
    __syncthreads();
}

namespace pg8 {
constexpr int BM = 256, BK = 64, HALF = 128, HTB = HALF * BK * 2, NXCD = 8, WGM = 8;
__host__ __device__ __forceinline__ int lds_byte(int r, int c) { const int st = (r >> 4) * 2 + (c >> 5), rr = r & 15, cc = c & 31, ob = rr * 64 + cc * 2; return st * 1024 + (ob ^ (((ob >> 9) & 1) << 5)); }
__host__ __device__ __forceinline__ void stage_rc(int b, int& R, int& C) { const int st = b / 1024, sb = b % 1024, swz = sb ^ (((sb >> 9) & 1) << 5); R = (st >> 1) * 16 + swz / 64; C = (st & 1) * 32 + (swz % 64) / 2; }
__host__ __device__ __forceinline__ int perm32(int rho) { const int n = rho >> 4, i = rho & 15; return 8 * (i >> 2) + 4 * n + (i & 3); }

struct Unit { int pm, pn, x0, x1, x2; };
__device__ __forceinline__ bool static_unit(long L, int nM, int nN, int& pm, int& pn) {
    const int nwg = nM * nN; if (L >= nwg) return false;
    int wgid = (int)L; { const int q = nwg / NXCD, r = nwg % NXCD, xcd = wgid % NXCD, off = wgid / NXCD; wgid = (xcd < r ? xcd * (q + 1) : r * (q + 1) + (xcd - r) * q) + off; }
    const int nig = WGM * nN, gid = wgid / nig, fm = gid * WGM, gsz = (nM - fm) < WGM ? (nM - fm) : WGM;
    const int wi = wgid % nig;
    if (gsz == WGM) { pm = fm + (wi & (WGM - 1)); pn = wi >> 3; }
    else { pm = fm + wi % gsz; pn = wi / gsz; }
    return true;
}

__host__ __device__ __forceinline__ int g8(int r) { return ((r >> 1) & 1) | (((r >> 3) & 1) << 2); }
__device__ __forceinline__ i32x8 cat8(bf16x8 a, bf16x8 b) { const i32x4 x = __builtin_bit_cast(i32x4, a), y = __builtin_bit_cast(i32x4, b); return __builtin_shufflevector(x, y, 0, 1, 2, 3, 4, 5, 6, 7); }
template <class Epi, class Sched, bool GATHER, bool FP8 = false>
__device__ __forceinline__ void gemm_phase(LAS unsigned char* lds, const int K, const Sched& S, const Epi& E, const int sA = 127, const int sB = 127) {
    const int tid = threadIdx.x, wid = __builtin_amdgcn_readfirstlane(tid >> 6), lane = tid & 63, wr = wid >> 2, wc = wid & 3, fr = lane & 15, fq = lane >> 4;
    const int pitch = FP8 ? K : 2 * K;
    int nt = pitch / 128; asm volatile("" : "+s"(nt));
    const size_t kstep = (size_t)128;
    const size_t hstep = (size_t)HALF * pitch;
    unsigned voffB[2], voffBh[2], aoC[2][2], aoN[2][2]; int Rl[2], Cb[2];
#pragma unroll
    for (int i = 0; i < 2; ++i) { int R, C;
        if constexpr (FP8) { const int pb = tid * 16 + i * 8192; R = pb >> 7; C = (((pb >> 4) & 7) ^ g8(R)) * 8; }
        else stage_rc(tid * 16 + i * 8192, R, C);
        const int Rb = (R & ~31) + perm32(R & 31);
        voffB[i] = (unsigned)(Rb * pitch + C * 2); voffBh[i] = voffB[i] + (unsigned)hstep; Rl[i] = R; Cb[i] = C * 2;
        aoC[0][i] = (unsigned)(R * pitch + C * 2); aoC[1][i] = aoC[0][i] + (unsigned)hstep; aoN[0][i] = aoC[0][i]; aoN[1][i] = aoC[1][i]; }
    const unsigned ldsw = (unsigned)wid * 1024u;
    const int aoff = FP8 ? (wr * 64 + fr) * 128 + ((32 * fq) ^ (g8(fr) << 4)) : lds_byte(wr * 64 + fr, fq * 8);
    const int boff = FP8 ? (wc * 32 + fr) * 128 + ((32 * fq) ^ (g8(fr) << 4)) : lds_byte(wc * 32 + fr, fq * 8);
#define PG8_AUX 0
#define PG8_SA(b, h) (((b) * 2 + (h)) * HTB)
#define PG8_SB(b, h) ((4 + (b) * 2 + (h)) * HTB)
#define PG8_STAGE(bufoff, gbase, voff) do { _Pragma("unroll") for (int _i = 0; _i < 2; ++_i) \
        __builtin_amdgcn_global_load_lds((const unsigned*)((const char*)(gbase) + (voff)[_i]), (LAS unsigned*)(lds + (bufoff) + ldsw + _i * 8192), 16, 0, PG8_AUX); } while (0)
#define PG8_LDA(dst, b, h) do { if constexpr (FP8) { _Pragma("unroll") for (int m = 0; m < 4; ++m) { const i32x4 lo_ = *(const LAS i32x4*)(lds + PG8_SA(b, h) + (aoff + m * 2048)), hi_ = *(const LAS i32x4*)(lds + PG8_SA(b, h) + ((aoff ^ 16) + m * 2048)); \
            dst##_8[m] = __builtin_shufflevector(lo_, hi_, 0, 1, 2, 3, 4, 5, 6, 7); } } \
        else { _Pragma("unroll") for (int m = 0; m < 4; ++m) _Pragma("unroll") for (int k = 0; k < 2; ++k) dst[m][k] = *(const LAS bf16x8*)(lds + PG8_SA(b, h) + aoff + m * 2048 + k * 1024); } } while (0)
#define PG8_LDB(dst, b, h) do { if constexpr (FP8) { _Pragma("unroll") for (int n = 0; n < 2; ++n) { const i32x4 lo_ = *(const LAS i32x4*)(lds + PG8_SB(b, h) + (boff + n * 2048)), hi_ = *(const LAS i32x4*)(lds + PG8_SB(b, h) + ((boff ^ 16) + n * 2048)); \
            dst##_8[n] = __builtin_shufflevector(lo_, hi_, 0, 1, 2, 3, 4, 5, 6, 7); } } \
        else { _Pragma("unroll") for (int n = 0; n < 2; ++n) _Pragma("unroll") for (int k = 0; k < 2; ++k) dst[n][k] = *(const LAS bf16x8*)(lds + PG8_SB(b, h) + boff + n * 2048 + k * 1024); } } while (0)
#define PG8_MMA(ai, bj, At, Bt) do { if constexpr (FP8) __builtin_amdgcn_sched_barrier(0); __builtin_amdgcn_s_setprio(1); \
        if constexpr (FP8) { _Pragma("unroll") for (int m = 0; m < 4; ++m) _Pragma("unroll") for (int n = 0; n < 2; ++n) \
            asm volatile("v_mfma_scale_f32_16x16x128_f8f6f4 %0, %1, %2, %0, %3, %4 op_sel_hi:[0,0,0]" : "+v"(acc[ai][bj][m][n]) : "v"(Bt##_8[n]), "v"(At##_8[m]), "v"(sBv), "v"(sAv)); \
            __builtin_amdgcn_sched_barrier(0); } \
        else { _Pragma("unroll") for (int m = 0; m < 4; ++m) _Pragma("unroll") for (int n = 0; n < 2; ++n) _Pragma("unroll") for (int k = 0; k < 2; ++k) \
            acc[ai][bj][m][n] = __builtin_amdgcn_mfma_f32_16x16x32_bf16(Bt[n][k], At[m][k], acc[ai][bj][m][n], 0, 0, 0); } \
        __builtin_amdgcn_s_setprio(0); } while (0)
#define PG8_WAIT_V(n) asm volatile("s_waitcnt vmcnt(" #n ")" ::: "memory")
#define PG8_WAIT_L(n) asm volatile("s_waitcnt lgkmcnt(" #n ")" ::: "memory")
#define PG8_BAR __builtin_amdgcn_s_barrier()
#define PG8_SCHED __builtin_amdgcn_sched_barrier(0)
    Unit cur, nxt; int ui = 0;
    if (!S.next(0, cur)) return;
    f32x4 acc[2][2][4][2];
#pragma unroll
    for (int a = 0; a < 2; ++a)
#pragma unroll
        for (int b = 0; b < 2; ++b)
#pragma unroll
            for (int m = 0; m < 4; ++m)
#pragma unroll
                for (int n = 0; n < 2; ++n) acc[a][b][m][n] = (f32x4){0.f, 0.f, 0.f, 0.f};
    bf16x8 At[4][2], B0[2][2], B1[2][2]; i32x8 At_8[4], B0_8[2], B1_8[2];
    int sAv = sA, sBv = sB; asm volatile("" : "+v"(sAv), "+v"(sBv));
    const char* cA = S.a_base(cur); const char* cB = S.b_base(cur);
    bool has_next = S.next(1, nxt);
    if constexpr (GATHER) { S.rows(cur, Rl, Cb, aoC); if (has_next) S.rows(nxt, Rl, Cb, aoN); else { aoN[0][0] = aoC[0][0]; aoN[0][1] = aoC[0][1]; aoN[1][0] = aoC[1][0]; aoN[1][1] = aoC[1][1]; } }
    PG8_STAGE(PG8_SB(0, 0), cB, voffB); PG8_STAGE(PG8_SB(0, 1), cB, voffBh); PG8_STAGE(PG8_SA(0, 0), cA, aoC[0]); PG8_STAGE(PG8_SA(0, 1), cA, aoC[1]);
    if (wr == 1) PG8_BAR;
    PG8_WAIT_V(2); PG8_BAR;
    PG8_STAGE(PG8_SB(1, 0), cB + kstep, voffB); PG8_STAGE(PG8_SA(1, 0), cA + kstep, aoC[0]); PG8_STAGE(PG8_SB(1, 1), cB + kstep, voffBh);
    PG8_WAIT_V(6); PG8_BAR;
    for (;;) {
        const char* nA = has_next ? S.a_base(nxt) : cA; const char* nB = has_next ? S.b_base(nxt) : cB;
#pragma unroll 1
        for (int t = 0; t < nt; t += 2) {
            const bool last = (t == nt - 2);
            const char* a1 = cA + (size_t)(t + 1) * kstep;
            const char* a2 = last ? nA : cA + (size_t)(t + 2) * kstep; const char* b2 = last ? nB : cB + (size_t)(t + 2) * kstep;
            const char* a3 = a2 + kstep; const char* b3 = b2 + kstep;
            unsigned o2[2][2];
            if constexpr (GATHER) { o2[0][0] = last ? aoN[0][0] : aoC[0][0]; o2[0][1] = last ? aoN[0][1] : aoC[0][1]; o2[1][0] = last ? aoN[1][0] : aoC[1][0]; o2[1][1] = last ? aoN[1][1] : aoC[1][1]; }
            else { o2[0][0] = aoC[0][0]; o2[0][1] = aoC[0][1]; o2[1][0] = aoC[1][0]; o2[1][1] = aoC[1][1]; }
            PG8_LDB(B0, 0, 0); PG8_LDB(B1, 0, 1); PG8_SCHED; PG8_LDA(At, 0, 0); PG8_STAGE(PG8_SA(1, 1), a1, aoC[1]);
            PG8_WAIT_V(8); PG8_WAIT_L(0); PG8_BAR; PG8_MMA(0, 0, At, B0); PG8_MMA(0, 1, At, B1); PG8_BAR; PG8_SCHED;
            PG8_LDA(At, 0, 1); PG8_STAGE(PG8_SB(0, 0), b2, voffB); PG8_STAGE(PG8_SB(0, 1), b2, voffBh); PG8_STAGE(PG8_SA(0, 0), a2, o2[0]);
            PG8_WAIT_V(8); PG8_WAIT_L(0); PG8_BAR; PG8_MMA(1, 0, At, B0); PG8_MMA(1, 1, At, B1); PG8_BAR; PG8_SCHED;
            PG8_LDB(B0, 1, 0); PG8_LDB(B1, 1, 1); PG8_SCHED; PG8_LDA(At, 1, 0); PG8_STAGE(PG8_SA(0, 1), a2, o2[1]);
            PG8_WAIT_V(8); PG8_WAIT_L(0); PG8_BAR; PG8_MMA(0, 0, At, B0); PG8_MMA(0, 1, At, B1); PG8_BAR; PG8_SCHED;
            PG8_LDA(At, 1, 1); PG8_STAGE(PG8_SB(1, 0), b3, voffB); PG8_STAGE(PG8_SB(1, 1), b3, voffBh); PG8_STAGE(PG8_SA(1, 0), a3, o2[0]);
            PG8_WAIT_V(8); PG8_WAIT_L(0); PG8_BAR; PG8_MMA(1, 0, At, B0); PG8_MMA(1, 1, At, B1); PG8_BAR; PG8_SCHED;
        }
        Unit nn; const bool has_nn = has_next && S.next(ui + 2, nn);
        unsigned aoNN[2][2];
        if constexpr (GATHER) { if (has_nn) S.rows(nn, Rl, Cb, aoNN); else { aoNN[0][0] = aoN[0][0]; aoNN[0][1] = aoN[0][1]; aoNN[1][0] = aoN[1][0]; aoNN[1][1] = aoN[1][1]; } }
        if (wr == 0) PG8_BAR;
        if constexpr (FP8) asm volatile("s_nop 15\n\ts_nop 15" ::: "memory");
        E(acc, cur, wr, wc, fr, fq);
        if (!has_next) break;
        if (!E.keep(cur)) {
#pragma unroll
            for (int a = 0; a < 2; ++a)
#pragma unroll
                for (int b = 0; b < 2; ++b)
#pragma unroll
                    for (int m = 0; m < 4; ++m)
#pragma unroll
                        for (int n = 0; n < 2; ++n) acc[a][b][m][n] = (f32x4){0.f, 0.f, 0.f, 0.f};
        }
        cur = nxt; cA = nA; cB = nB; ++ui; nxt = nn; has_next = has_nn;
        if constexpr (GATHER) { aoC[0][0] = aoN[0][0]; aoC[0][1] = aoN[0][1]; aoC[1][0] = aoN[1][0]; aoC[1][1] = aoN[1][1];
                                aoN[0][0] = aoNN[0][0]; aoN[0][1] = aoNN[0][1]; aoN[1][0] = aoNN[1][0]; aoN[1][1] = aoNN[1][1]; }
        if (wr == 1) PG8_BAR;
    }
    PG8_WAIT_V(0);
    PG8_BAR;
#undef PG8_SA
#undef PG8_SB
#undef PG8_STAGE
#undef PG8_LDA
#undef PG8_LDB
#undef PG8_MMA
#undef PG8_WAIT_V
#undef PG8_WAIT_L
#undef PG8_BAR
#undef PG8_SCHED
}
}
using pg8::Unit;

struct Frame {
    LAS unsigned char* lds;
    volatile LAS unsigned* MISC;
    gu32* ctl;
    int tid, lane, wave, vcu, G;
    unsigned char* ws; unsigned char* outb;
    const float* const __attribute__((address_space(4)))* in;
};

__device__ __forceinline__ float wave_sum(float v) {
#pragma unroll
    for (int o = 1; o < 64; o <<= 1) v += __shfl_xor(v, o);
    return v;
}

struct CvtItem { const float* W; bf16* WT; const float* gain; int ldw, Kd; int f8; float osc; };
struct CvtGain { f32x4 g0, g1; };
__device__ __forceinline__ void cvt_load(const CvtItem& it, int lane, f32x4 (&v)[8], CvtGain& gg) {
    if (it.gain) { gg.g0 = *(const f32x4*)(it.gain + 8 * (lane & 7)); gg.g1 = *(const f32x4*)(it.gain + 8 * (lane & 7) + 4); }
    const float* p = it.W + (size_t)(8 * (lane & 7)) * it.ldw + 4 * (lane >> 3);
#pragma unroll
    for (int i = 0; i < 8; ++i) v[i] = __builtin_nontemporal_load((const f32x4*)(p + (size_t)i * it.ldw));
}
__device__ __forceinline__ void cvt_store(const CvtItem& it, int lane, f32x4 (&v)[8], const CvtGain& gg) {
    const int kc = lane & 7, ng = lane >> 3;
    if (it.gain) { const f32x4 g0 = gg.g0, g1 = gg.g1;
#pragma unroll
        for (int i = 0; i < 4; ++i) { v[i] = v[i] * g0[i]; v[4 + i] = v[4 + i] * g1[i]; } }
    if (it.f8) {
        const bool odd = (kc & 1) != 0;
#pragma unroll
        for (int h = 0; h < 2; ++h) {
            u32x2 lo, hi;
            lo.x = pk4_fp8(v[0][h] * W8_SCALE, v[1][h] * W8_SCALE, v[2][h] * W8_SCALE, v[3][h] * W8_SCALE); lo.y = pk4_fp8(v[4][h] * W8_SCALE, v[5][h] * W8_SCALE, v[6][h] * W8_SCALE, v[7][h] * W8_SCALE);
            hi.x = pk4_fp8(v[0][2 + h] * W8_SCALE, v[1][2 + h] * W8_SCALE, v[2][2 + h] * W8_SCALE, v[3][2 + h] * W8_SCALE); hi.y = pk4_fp8(v[4][2 + h] * W8_SCALE, v[5][2 + h] * W8_SCALE, v[6][2 + h] * W8_SCALE, v[7][2 + h] * W8_SCALE);
            const unsigned gx = odd ? lo.x : hi.x, gy = odd ? lo.y : hi.y, kx = odd ? hi.x : lo.x, ky = odd ? hi.y : lo.y;
            const unsigned rx = (unsigned)__builtin_amdgcn_update_dpp(0, (int)gx, 0xB1, 0xF, 0xF, false), ry = (unsigned)__builtin_amdgcn_update_dpp(0, (int)gy, 0xB1, 0xF, 0xF, false);
            u32x4 w; w.x = odd ? rx : kx; w.y = odd ? ry : ky; w.z = odd ? kx : rx; w.w = odd ? ky : ry;
            __builtin_nontemporal_store(w, (u32x4*)((unsigned char*)it.WT + (size_t)(4 * ng + (odd ? 2 : 0) + h) * it.Kd + 8 * (kc & ~1))); }
        return; }
#pragma unroll
    for (int q = 0; q < 4; ++q) { u32x4 o; const float sc_ = it.osc; o.x = cvt_pk_bf16(v[0][q] * sc_, v[1][q] * sc_); o.y = cvt_pk_bf16(v[2][q] * sc_, v[3][q] * sc_); o.z = cvt_pk_bf16(v[4][q] * sc_, v[5][q] * sc_); o.w = cvt_pk_bf16(v[6][q] * sc_, v[7][q] * sc_);
        *(u32x4*)(it.WT + (size_t)(4 * ng + q) * it.Kd + 8 * kc) = o; }
}
constexpr int I_IN = 16 * 208, I_SQ = 16 * 32, I_G = 32 * 16 * 16, I_D = 32 * 8 * 32;
constexpr int N_CVT_ITEMS = I_IN + 3 * I_SQ + 2 * I_G + I_D;
constexpr int N_CVT_P0 = I_IN + 3 * I_SQ;
constexpr int N_SIDE_UNITS = 0;
constexpr int N_SIDE_ITEMS = N_SIDE_UNITS * 256 * 8;
constexpr int CW_FILL = 3072;
constexpr unsigned FILL_N0 = (unsigned)(3 * I_SQ) / 8u;
constexpr unsigned FILL_NA = FILL_N0 + (unsigned)(2 * I_G - N_SIDE_ITEMS) / 8u;
__device__ __forceinline__ CvtItem cvt_decode(const Frame& F, int r) {
    CvtItem c; c.gain = nullptr; c.f8 = 0; c.osc = 1.f;
    bf16* WIN = (bf16*)(F.ws + WS_WIN); unsigned char* WGU = F.ws + WS_WGU; unsigned char* WD = F.ws + WS_WD;
    if (r < I_IN) { const int kb = r / 208, nb = r % 208, n0 = 32 * nb; int dr = n0;
        if (n0 >= 1024 && n0 < 2048) { const int ch = n0 - 1024; dr = 1024 + 256 * (ch >> 7) + (ch & 127); }
        else if (n0 >= 2048 && n0 < 3072) { const int ch = n0 - 2048; dr = 1024 + 256 * (ch >> 7) + 128 + (ch & 127); }
        else if (n0 >= 4608 && n0 < 5632) { const int ch = n0 - 4608; dr = 4608 + 256 * (ch >> 7) + (ch & 127); }
        else if (n0 >= 5632) { const int ch = n0 - 5632; dr = 4608 + 256 * (ch >> 7) + 128 + (ch & 127); }
        c.osc = (n0 >= 3072 && n0 < 4096) ? QSCALE : (n0 >= 4608 ? -LOG2E : 1.f);
        c.W = F.in[2] + (size_t)(64 * kb) * NCOL + n0; c.ldw = NCOL; c.WT = WIN + (size_t)dr * D + 64 * kb; c.Kd = D; return c; }
    r -= I_IN;
    if (r < 3 * I_SQ) { const int w = r / I_SQ, q = r % I_SQ, kb = q / 32, nb = q % 32;
        const float* s0 = F.in[5]; const float* s1 = F.in[7]; const float* s2 = F.in[8];
        asm volatile("" : "+s"(s0)); asm volatile("" : "+s"(s1)); asm volatile("" : "+s"(s2));
        const float* src = (w == 0) ? s0 : (w == 1) ? s1 : s2;
        c.W = src + (size_t)(64 * kb) * D + 32 * nb; c.ldw = D; c.WT = (bf16*)(F.ws + WS_WA + (size_t)w * 2 * MiB) + (size_t)(32 * nb) * D + 64 * kb; c.Kd = D; return c; }
    r -= 3 * I_SQ;
    if (r < 2 * I_G) { const int up = r / I_G, rr = r % I_G, e = rr / 256, q = rr % 256, kb = q / 16, nb = q % 16, f0 = 32 * nb;
        const float* g0 = F.in[14]; const float* g1 = F.in[15]; asm volatile("" : "+s"(g0)); asm volatile("" : "+s"(g1));
        c.W = (up ? g1 : g0) + (size_t)e * D * FF + (size_t)(64 * kb) * FF + f0; c.ldw = FF;
        c.WT = (bf16*)(WGU + (size_t)e * D * D + (size_t)(256 * (f0 >> 7) + 128 * up + (f0 & 127)) * D + 64 * kb); c.Kd = D; c.gain = F.in[9] + 64 * kb; c.f8 = 1; return c; }
    r -= 2 * I_G;
    { const int e = r / 256, q = r % 256, kb = q / 32, nb = q % 32;
      c.W = F.in[16] + (size_t)e * FF * D + (size_t)(64 * kb) * D + 32 * nb; c.ldw = D; c.WT = (bf16*)(WD + (size_t)e * D * FF + (size_t)(32 * nb) * FF + 64 * kb); c.Kd = FF; c.f8 = 1; return c; }
}

__device__ __forceinline__ void p0_prologue(Frame& F) {
    const int gw = F.vcu * NWAVES + F.wave, NGW = F.G * NWAVES;
    if (F.tid < 24) { const float* wg = F.in[10]; const float* we = F.in[12]; const float* g_ffn = F.in[9]; u32x4* RWF = (u32x4*)(F.ws + WS_RWF);
        const int idx = F.vcu * 24 + F.tid;
        const int l = idx & 63, st = idx >> 6, t = st % 3, s = st / 3, col = 16 * t + (l & 15), k0 = 64 * (s >> 1) + 16 * (l >> 4) + 8 * (s & 1);
        float wa[8], wb[8], gk[8];
#pragma unroll
        for (int j = 0; j < 8; ++j) { const int k = k0 + j; wa[j] = wg[k * 4 + (col & 3)]; wb[j] = we[k * 32 + ((col - 4) & 31)]; gk[j] = g_ffn[k]; }
        unsigned hi[8], lo[8];
#pragma unroll
        for (int j = 0; j < 8; ++j) { float w = (col < 4) ? wa[j] : ((col < 36) ? wb[j] : 0.f);
            w *= gk[j]; const unsigned h = f2bf(w); hi[j] = h; lo[j] = f2bf(w - bf2f((unsigned short)h)); }
        u32x4 vh, vl; vh.x = hi[0] | (hi[1] << 16); vh.y = hi[2] | (hi[3] << 16); vh.z = hi[4] | (hi[5] << 16); vh.w = hi[6] | (hi[7] << 16);
        vl.x = lo[0] | (lo[1] << 16); vl.y = lo[2] | (lo[3] << 16); vl.z = lo[4] | (lo[5] << 16); vl.w = lo[6] | (lo[7] << 16);
        RWF[((size_t)st * 2 + 0) * 64 + l] = vh; RWF[((size_t)st * 2 + 1) * 64 + l] = vl; }
    { const float* x = F.in[0]; const float* g = F.in[1]; bf16* H = (bf16*)(F.ws + WS_H);
      f32x4 gv[4];
#pragma unroll
      for (int j = 0; j < 4; ++j) gv[j] = *((const GAS f32x4*)g + F.lane + 64 * j);
      auto ldrows = [&](f32x4 (&dst)[4][4], int m0) {
#pragma unroll
        for (int r = 0; r < 4; ++r) { const GAS f32x4* xa = (const GAS f32x4*)(x + (size_t)(m0 + r) * D) + F.lane;
#pragma unroll
            for (int j = 0; j < 4; ++j) dst[r][j] = __builtin_nontemporal_load(xa + 64 * j); } };
      f32x4 v[4][4], vn[4][4];
      if (4 * gw < M) ldrows(v, 4 * gw);
      for (int m = 4 * gw; m < M; m += 4 * NGW) {
        int mr[4]; float ss[4];
#pragma unroll
        for (int r = 0; r < 4; ++r) mr[r] = m + r;
        const bool more_rows = (m + 4 * NGW < M);
        if (more_rows) ldrows(vn, m + 4 * NGW);
#pragma unroll
        for (int r = 0; r < 4; ++r) { float sa = 0.f;
#pragma unroll
            for (int j = 0; j < 4; ++j) sa += (v[r][j].x * v[r][j].x + v[r][j].y * v[r][j].y) + (v[r][j].z * v[r][j].z + v[r][j].w * v[r][j].w);
            ss[r] = sa; }
#pragma unroll
        for (int o = 1; o < 64; o <<= 1) {
#pragma unroll
            for (int r = 0; r < 4; ++r) ss[r] += __shfl_xor(ss[r], o); }
#pragma unroll
        for (int r = 0; r < 4; ++r) { const float rq = sqrtf(ss[r] * (1.f / D) + EPS), ra = 1.0f / rq; GAS u32x2* oa = (GAS u32x2*)(H + (size_t)mr[r] * D) + F.lane;
            if (F.lane == 0) { const int rr = mr[r] & 255;
                ((float*)(F.ws + WS_RI))[(mr[r] & ~255) + ((((rr >> 7) * 2 + ((rr >> 6) & 1)) * 16 + (rr & 15)) << 2) + ((rr >> 4) & 3)] = rq; }
            const bool odd = (F.lane & 1) != 0;
#pragma unroll
            for (int jp = 0; jp < 2; ++jp) { u32x2 w[2];
#pragma unroll
                for (int h = 0; h < 2; ++h) { const int j = 2 * jp + h; w[h].x = cvt_pk_bf16(v[r][j].x * ra * gv[j].x, v[r][j].y * ra * gv[j].y); w[h].y = cvt_pk_bf16(v[r][j].z * ra * gv[j].z, v[r][j].w * ra * gv[j].w); }
                const unsigned gx = odd ? w[0].x : w[1].x, gy = odd ? w[0].y : w[1].y, kx = odd ? w[1].x : w[0].x, ky = odd ? w[1].y : w[0].y;
                const unsigned rx = (unsigned)__builtin_amdgcn_update_dpp(0, (int)gx, 0xB1, 0xF, 0xF, false), ry = (unsigned)__builtin_amdgcn_update_dpp(0, (int)gy, 0xB1, 0xF, 0xF, false);
                u32x4 o; o.x = odd ? rx : kx; o.y = odd ? ry : ky; o.z = odd ? kx : rx; o.w = odd ? ky : ry;
                *(GAS u32x4*)((GAS u32x2*)oa + 64 * (2 * jp + (odd ? 1 : 0)) - (odd ? 1 : 0)) = o; } }
        if (more_rows) {
#pragma unroll
            for (int r = 0; r < 4; ++r)
#pragma unroll
                for (int j = 0; j < 4; ++j) v[r][j] = vn[r][j]; }
      } }
    for (int it = gw; it < I_IN; it += 2 * NGW) {
        const int it2 = (it + NGW < I_IN) ? it + NGW : it;
        const CvtItem ca = cvt_decode(F, it), cb = cvt_decode(F, it2);
        f32x4 va[8], vb[8];
        CvtGain ga_, gb_; cvt_load(ca, F.lane, va, ga_); cvt_load(cb, F.lane, vb, gb_);
        cvt_store(ca, F.lane, va, ga_); cvt_store(cb, F.lane, vb, gb_);
    }
}

constexpr size_t TSTEP1024 = (size_t)256 * 1024 * 2;
struct SchedPlain {
    const char* A; const char* Bt; int nM, nN, G, c; size_t tstep;
    __device__ __forceinline__ bool next(int i, Unit& u) const { u.x0 = 0; u.x1 = i; u.x2 = 0; return pg8::static_unit((long)i * G + c, nM, nN, u.pm, u.pn); }
    __device__ __forceinline__ const char* a_base(const Unit& u) const { return A + (size_t)u.pm * tstep; }
    __device__ __forceinline__ const char* b_base(const Unit& u) const { return Bt + (size_t)u.pn * tstep; }
    __device__ __forceinline__ void rows(const Unit&, const int*, const int*, unsigned (&)[2][2]) const {}
};
struct SchedG1 {
    const char* A; const char* Bt; int c;
    __device__ __forceinline__ bool next(int i, Unit& u) const { u.x0 = 0; u.x1 = i; u.x2 = 0; if (i >= 13) return false;
        if (i < 3) { int sx; pg8::static_unit((long)i * 256 + c, M / 256, 6, u.pm, sx); u.pn = 12 + sx; }
        else if (i < 7) { int sx; pg8::static_unit((long)(i - 3) * 256 + c, M / 256, 8, u.pm, sx); u.pn = 18 + sx; }
        else { const int j = (i - 7) / 3, part = (i - 7) % 3; int ti; pg8::static_unit((long)j * 256 + c, M / 256, 4, u.pm, ti); u.pn = (part < 2) ? 4 + 2 * ti + part : ti; }
        return true; }
    __device__ __forceinline__ const char* a_base(const Unit& u) const { return A + (size_t)u.pm * TSTEP1024; }
    __device__ __forceinline__ const char* b_base(const Unit& u) const { return Bt + (size_t)u.pn * TSTEP1024; }
    __device__ __forceinline__ void rows(const Unit&, const int*, const int*, unsigned (&)[2][2]) const {}
};
struct SchedDual {
    const char* A0; long dA; const char* B0; long dB; int nM, nN, G, c;
    __device__ __forceinline__ bool next(int i, Unit& u) const { u.x0 = i & 1; u.x1 = 0; u.x2 = 0; return pg8::static_unit((long)(i >> 1) * G + c, nM, nN, u.pm, u.pn); }
    __device__ __forceinline__ const char* a_base(const Unit& u) const { return A0 + ((-(long)u.x0) & dA) + (size_t)u.pm * TSTEP1024; }
    __device__ __forceinline__ const char* b_base(const Unit& u) const { return B0 + ((-(long)u.x0) & dB) + (size_t)u.pn * TSTEP1024; }
    __device__ __forceinline__ void rows(const Unit&, const int*, const int*, unsigned (&)[2][2]) const {}
};
struct SchedMoE {
    const char* A; const char* Bt; const LAS int* pfx; const int* ltok; int G, c; int K; size_t a_tstep, b_estep, b_tstep; bool gather;
    __device__ __forceinline__ bool next(int i, Unit& u) const {
        const int nM = pfx[32];
        if (!pg8::static_unit((long)i * G + c, nM, 4, u.pm, u.pn)) return false;
        const int e = __builtin_amdgcn_readfirstlane(pfx[T2E_OFF_WORDS + u.pm]);
        const int mt = u.pm - pfx[e];
        u.x0 = e; u.x1 = pfx[40 + e] - 256 * mt; u.x2 = e * CAP + 256 * mt; return true;
    }
    __device__ __forceinline__ const char* a_base(const Unit& u) const { return gather ? A : A + (size_t)u.pm * a_tstep; }
    __device__ __forceinline__ const char* b_base(const Unit& u) const { return Bt + (size_t)u.x0 * b_estep + (size_t)u.pn * b_tstep; }
    __device__ __forceinline__ void rows(const Unit& u, const int* Rl, const int* Cb, unsigned (&off)[2][2]) const {
#pragma unroll
        for (int h = 0; h < 2; ++h)
#pragma unroll
            for (int i = 0; i < 2; ++i) { const int rl = h * 128 + Rl[i]; const int tok = ltok[u.x2 + (rl < u.x1 ? rl : 0)] >> 1;
                off[h][i] = (unsigned)tok * (unsigned)K + (unsigned)Cb[i]; }
    }
};

struct EpiG1 {
    bf16 *Bo  , *CUo, *Qo, *Ko, *Vo, *GAo, *GBo, *B2o; const Frame* F; int G, c; XcdBarrier sb; bool split;
    __device__ __forceinline__ bool keep(const Unit&) const { return false; }
    __device__ __forceinline__ void operator()(f32x4 (&acc)[2][2][4][2], const Unit& u, int wr, int wc, int fr, int fq) const {
        const int sidx = N_CVT_P0 + (u.x1 * G + c) * NWAVES + (wr * 4 + wc); const bool side = u.x1 < N_SIDE_UNITS;
        CvtItem sc; f32x4 sv[8]; CvtGain sg;
        if (side) { sc = cvt_decode(*F, sidx); cvt_load(sc, fr + 16 * fq, sv, sg); }
        if (u.pn < 4) { if (side) cvt_store(sc, fr + 16 * fq, sv, sg); body(acc, u, wr, wc, fr, fq); return; }
        body(acc, u, wr, wc, fr, fq);
        if (side) cvt_store(sc, fr + 16 * fq, sv, sg);
        if (split && u.x1 == 2) { asm volatile("s_waitcnt vmcnt(0)" ::: "memory"); xcd_split_arrive(sb, 0); }
    }
    __device__ __forceinline__ void conv_tile(f32x4 (&acc)[2][2][4][2], const Unit& u, int wr, int wc, int fr_, int fq_) const {
        int fr = fr_, fq = fq_; asm volatile("" : "+v"(fr), "+v"(fq));
        const LAS float* cwl = (const LAS float*)(F->lds + CONVW_OFF);
        const int lane = fr + 16 * fq, src1 = (lane & ~15) | ((fr - 1) & 15), src2 = (lane & ~15) | ((fr - 2) & 15);
#pragma unroll
        for (int bj = 0; bj < 2; ++bj) {
            const int ch0 = 256 * u.pn + 128 * bj + 32 * wc + 8 * fq;
            float w0[8], w1[8], w2[8], cbv[8];
#pragma unroll
            for (int q = 0; q < 2; ++q) { const f32x4 a0 = *(const LAS f32x4*)(cwl + ch0 + 4 * q), a1 = *(const LAS f32x4*)(cwl + D + ch0 + 4 * q), a2 = *(const LAS f32x4*)(cwl + 2 * D + ch0 + 4 * q), a3 = *(const LAS f32x4*)(cwl + 3 * D + ch0 + 4 * q);
#pragma unroll
                for (int e = 0; e < 4; ++e) { w0[4 * q + e] = a0[e]; w1[4 * q + e] = a1[e]; w2[4 * q + e] = a2[e]; cbv[4 * q + e] = a3[e]; } }
#pragma unroll
            for (int ai = 0; ai < 2; ++ai) {
                asm volatile("" ::: "memory");
                const int t0 = u.pm * 256 + ai * 128 + wr * 64;
                u32x4 cur[5];
#pragma unroll
                for (int m = 0; m < 5; ++m) { int row = t0 - 16 + 16 * m + fr; row = row < 0 ? 0 : row;
                    cur[m] = *(const u32x4*)((const char*)CUo + (unsigned)(row * D + ch0) * 2u); }
#pragma unroll
                for (int m = 0; m < 4; ++m) {
                    const u32x4 c = cur[m + 1], pv = cur[m]; u32x4 t1, t2;
#pragma unroll
                    for (int e = 0; e < 4; ++e) {
                        const unsigned c1 = (unsigned)__builtin_amdgcn_update_dpp(0, (int)c[e], 0x121, 0xF, 0xF, false), p1 = (unsigned)__builtin_amdgcn_update_dpp(0, (int)pv[e], 0x121, 0xF, 0xF, false);
                        const unsigned c2 = (unsigned)__builtin_amdgcn_update_dpp(0, (int)c[e], 0x122, 0xF, 0xF, false), p2 = (unsigned)__builtin_amdgcn_update_dpp(0, (int)pv[e], 0x122, 0xF, 0xF, false);
                        t1[e] = (fr >= 1) ? c1 : p1; t2[e] = (fr >= 2) ? c2 : p2; }
                    float fc[8], f1[8], f2[8], y[8]; unpack8(c, fc); unpack8(t1, f1); unpack8(t2, f2);
#pragma unroll
                    for (int n = 0; n < 2; ++n)
#pragma unroll
                        for (int q = 0; q < 4; ++q) { const int k = 4 * n + q; y[k] = acc[ai][bj][m][n][q] * (w0[k] * f2[k] + w1[k] * f1[k] + w2[k] * fc[k] + cbv[k]); }
                    u32x4 w; w.x = cvt_pk_bf16(y[0], y[1]); w.y = cvt_pk_bf16(y[2], y[3]); w.z = cvt_pk_bf16(y[4], y[5]); w.w = cvt_pk_bf16(y[6], y[7]);
                    *(u32x4*)((char*)Bo + (unsigned)((t0 + 16 * m + fr) * D + ch0) * 2u) = w;
                    if (ai == 0 && m == 0 && wr == 0 && fr < 2) {
                        u32x4 wb; wb.x = cvt_pk_bf16(acc[0][bj][0][0][0], acc[0][bj][0][0][1]); wb.y = cvt_pk_bf16(acc[0][bj][0][0][2], acc[0][bj][0][0][3]);
                        wb.z = cvt_pk_bf16(acc[0][bj][0][1][0], acc[0][bj][0][1][1]); wb.w = cvt_pk_bf16(acc[0][bj][0][1][2], acc[0][bj][0][1][3]);
                        *(u32x4*)((char*)B2o + (unsigned)((u.pm * 2 + fr) * D + ch0) * 2u) = wb; }
                } } }
    }
    __device__ __forceinline__ void body(f32x4 (&acc)[2][2][4][2], const Unit& u, int wr, int wc, int fr_, int fq_) const {
        int fr = fr_, fq = fq_; asm volatile("" : "+v"(fr), "+v"(fq));
        const int row0 = u.pm * 256 + wr * 64 + fr, pn = u.pn, cb = wc * 32 + 8 * fq;
        if (pn >= 4 && pn < 12) {
#pragma unroll
            for (int ai = 0; ai < 2; ++ai)
#pragma unroll
                for (int m = 0; m < 4; ++m) { bf16* rowp = CUo + (size_t)(row0 + ai * 128 + m * 16) * D + 128 * (pn - 4) + cb;
                    const f32x4 v0 = acc[ai][0][m][0] * acc[ai][1][m][0], v1 = acc[ai][0][m][1] * acc[ai][1][m][1];
                    u32x4 w; w.x = cvt_pk_bf16(v0[0], v0[1]); w.y = cvt_pk_bf16(v0[2], v0[3]); w.z = cvt_pk_bf16(v1[0], v1[1]); w.w = cvt_pk_bf16(v1[2], v1[3]);
                    *(u32x4*)rowp = w; }
            return;
        }
        if (pn < 4) { conv_tile(acc, u, wr, wc, fr, fq); return; }
        bf16* base; int ldc = D, col = cb; int mode = 0;
        if (pn < 16) { base = Qo; col += 256 * (pn - 12); }
        else if (pn == 16) { base = Ko; ldc = KVW; }
        else if (pn == 17) { base = Vo; ldc = KVW; }
        else { base = GAo; col += 128 * (pn - 18); mode = 2; }
#pragma unroll
        for (int ai = 0; ai < 2; ++ai)
#pragma unroll
            for (int m = 0; m < 4; ++m) { bf16* rowp = base + (size_t)(row0 + ai * 128 + m * 16) * ldc + col;
                if (mode == 2) {
                    float ra[8], sbv[8];
#pragma unroll
                    for (int n = 0; n < 2; ++n)
#pragma unroll
                        for (int q = 0; q < 4; ++q) { const float ea = __builtin_amdgcn_exp2f(acc[ai][0][m][n][q]), eb = __builtin_amdgcn_exp2f(acc[ai][1][m][n][q]);
                            const float sb = __builtin_amdgcn_rcpf(1.0f + eb); sbv[4 * n + q] = sb; ra[4 * n + q] = __builtin_amdgcn_rcpf((1.0f + ea) * fmaxf(sb, 1e-30f)); }
                    u32x4 w; w.x = cvt_pk_bf16(ra[0], ra[1]); w.y = cvt_pk_bf16(ra[2], ra[3]); w.z = cvt_pk_bf16(ra[4], ra[5]); w.w = cvt_pk_bf16(ra[6], ra[7]); __builtin_nontemporal_store(w, (u32x4*)rowp);
                    u32x4 v; v.x = cvt_pk_bf16(sbv[0], sbv[1]); v.y = cvt_pk_bf16(sbv[2], sbv[3]); v.z = cvt_pk_bf16(sbv[4], sbv[5]); v.w = cvt_pk_bf16(sbv[6], sbv[7]);
                    __builtin_nontemporal_store(v, (u32x4*)(GBo + (size_t)(row0 + ai * 128 + m * 16) * D + col));
                } else {
#pragma unroll
                    for (int bj = 0; bj < 2; ++bj) { const f32x4 v0 = acc[ai][bj][m][0], v1 = acc[ai][bj][m][1];
                        u32x4 w; w.x = cvt_pk_bf16(v0[0], v0[1]); w.y = cvt_pk_bf16(v0[2], v0[3]); w.z = cvt_pk_bf16(v1[0], v1[1]); w.w = cvt_pk_bf16(v1[2], v1[3]);
                        *(u32x4*)(rowp + bj * 128) = w; } } }
    }
};
struct EpiG3 {
    const bf16* GA; const bf16* GB; bf16* MO;
    __device__ __forceinline__ bool keep(const Unit& u) const { return u.x0 == 0; }
    __device__ __forceinline__ void operator()(f32x4 (&acc)[2][2][4][2], const Unit& u, int wr, int wc, int fr, int fq) const {
        const int row0 = u.pm * 256 + wr * 64 + fr, col0 = u.pn * 256 + wc * 32 + 8 * fq;
        const unsigned off0 = (unsigned)(row0 * D + col0) * 2u;
#define G3_LD(P, ai, m, bj) (*(const u32x4*)((const char*)(P) + off0 + (unsigned)(((ai) * 128 + (m) * 16) * D + (bj) * 128) * 2u))
        u32x4 gv[2][4][2];
        if (u.x0 == 0) {
#pragma unroll
            for (int ai = 0; ai < 2; ++ai)
#pragma unroll
                for (int m = 0; m < 4; ++m)
#pragma unroll
                    for (int bj = 0; bj < 2; ++bj) gv[ai][m][bj] = G3_LD(GA, ai, m, bj);
            __builtin_amdgcn_sched_barrier(0);
#pragma unroll
            for (int ai = 0; ai < 2; ++ai)
#pragma unroll
                for (int m = 0; m < 4; ++m)
#pragma unroll
                    for (int bj = 0; bj < 2; ++bj) { float a[8]; unpack8(gv[ai][m][bj], a);
#pragma unroll
                        for (int q = 0; q < 4; ++q) { acc[ai][bj][m][0][q] *= a[q]; acc[ai][bj][m][1][q] *= a[4 + q]; } }
        } else {
#pragma unroll
            for (int ai = 0; ai < 2; ++ai)
#pragma unroll
                for (int m = 0; m < 4; ++m)
#pragma unroll
                    for (int bj = 0; bj < 2; ++bj) gv[ai][m][bj] = G3_LD(GB, ai, m, bj);
            __builtin_amdgcn_sched_barrier(0);
#pragma unroll
            for (int ai = 0; ai < 2; ++ai)
#pragma unroll
                for (int m = 0; m < 4; ++m)
#pragma unroll
                    for (int bj = 0; bj < 2; ++bj) { float b[8]; unpack8(gv[ai][m][bj], b);
                        f32x4 v0 = acc[ai][bj][m][0], v1 = acc[ai][bj][m][1];
#pragma unroll
                        for (int q = 0; q < 4; ++q) { v0[q] *= fmaxf(b[q], 1e-30f); v1[q] *= fmaxf(b[4 + q], 1e-30f); }
                        u32x4 w; w.x = cvt_pk_bf16(v0[0], v0[1]); w.y = cvt_pk_bf16(v0[2], v0[3]); w.z = cvt_pk_bf16(v1[0], v1[1]); w.w = cvt_pk_bf16(v1[2], v1[3]);
                        *(u32x4*)((char*)MO + off0 + (unsigned)((ai * 128 + m * 16) * D + bj * 128) * 2u) = w; }
        }
#undef G3_LD
    }
};
struct EpiG4 {
    const bf16* Hn; const float* RI; const float* gmix; bf16* X1;
    __device__ __forceinline__ bool keep(const Unit&) const { return false; }
    __device__ __forceinline__ void operator()(f32x4 (&acc)[2][2][4][2], const Unit& u, int wr, int wc, int fr, int fq) const {
        const int row0 = u.pm * 256 + wr * 64 + fr, col0 = u.pn * 256 + wc * 32 + 8 * fq;
        float gi[2][8];
#pragma unroll
        for (int bj = 0; bj < 2; ++bj) { const f32x4 g0 = *(const f32x4*)(gmix + col0 + bj * 128), g1 = *(const f32x4*)(gmix + col0 + bj * 128 + 4);
#pragma unroll
            for (int q = 0; q < 4; ++q) { gi[bj][q] = __builtin_amdgcn_rcpf(g0[q]); gi[bj][4 + q] = __builtin_amdgcn_rcpf(g1[q]); } }
#pragma unroll
        for (int ai = 0; ai < 2; ++ai) {
            u32x4 hv[4][2]; const f32x4 ri = *(const f32x4*)(RI + (row0 & ~255) + (((ai * 2 + wr) * 16 + fr) << 2));
#pragma unroll
            for (int m = 0; m < 4; ++m) { const int row = row0 + ai * 128 + m * 16;
#pragma unroll
                for (int bj = 0; bj < 2; ++bj) hv[m][bj] = *(const u32x4*)(Hn + (size_t)row * D + col0 + bj * 128); }
            __builtin_amdgcn_sched_barrier(0);
#pragma unroll
            for (int m = 0; m < 4; ++m)
#pragma unroll
                for (int bj = 0; bj < 2; ++bj) { float hx[8]; unpack8(hv[m][bj], hx); f32x4 v0 = acc[ai][bj][m][0], v1 = acc[ai][bj][m][1];
#pragma unroll
                    for (int q = 0; q < 4; ++q) { v0[q] += hx[q] * ri[m] * gi[bj][q]; v1[q] += hx[4 + q] * ri[m] * gi[bj][4 + q]; }
                    u32x4 w; w.x = cvt_pk_bf16(v0[0], v0[1]); w.y = cvt_pk_bf16(v0[2], v0[3]); w.z = cvt_pk_bf16(v1[0], v1[1]); w.w = cvt_pk_bf16(v1[2], v1[3]);
                    *(u32x4*)(X1 + (size_t)(row0 + ai * 128 + m * 16) * D + col0 + bj * 128) = w; } }
    }
};
struct EpiG6 {
    const f32x2* LRW; bf16* ACT;
    __device__ __forceinline__ bool keep(const Unit&) const { return false; }
    __device__ __forceinline__ void operator()(f32x4 (&acc)[2][2][4][2], const Unit& u, int wr, int wc, int fr, int fq) const {
        const int rl0 = wr * 64 + fr, col0 = u.pn * 128 + wc * 32 + 8 * fq;
        f32x2 rw[2][4];
#pragma unroll
        for (int ai = 0; ai < 2; ++ai) {
            const f32x4* src = (const f32x4*)(LRW + u.x2 + (((ai * 2 + wr) * 16 + fr) << 2)); const f32x4 a = src[0], b = src[1];
            rw[ai][0] = (f32x2){a.x, a.y}; rw[ai][1] = (f32x2){a.z, a.w}; rw[ai][2] = (f32x2){b.x, b.y}; rw[ai][3] = (f32x2){b.z, b.w}; }
        const int odd = fq & 1, partner = ((fr + 16 * fq) ^ 16) * 4;
#pragma unroll
        for (int ai = 0; ai < 2; ++ai)
#pragma unroll
            for (int mp = 0; mp < 2; ++mp) { u32x2 w[2];
#pragma unroll
                for (int h = 0; h < 2; ++h) { const int m = 2 * mp + h; const int rl = rl0 + ai * 128 + m * 16; const bool ok = rl < u.x1; const float rs = ok ? rw[ai][m].x : 0.f, wsv = ok ? rw[ai][m].y : 0.f;
                    const float c2 = -LOG2E * rs, c3 = wsv * rs * rs * A8_SCALE;
                    f32x4 o[2];
#pragma unroll
                    for (int n = 0; n < 2; ++n) { const f32x4 ag = acc[ai][0][m][n], au = acc[ai][1][m][n]; const f32x4 p = ag * au, ea = ag * c2; f32x4 r;
#pragma unroll
                        for (int q = 0; q < 4; ++q) r[q] = __builtin_amdgcn_rcpf(1.0f + __builtin_amdgcn_exp2f(ea[q]));
                        o[n] = (p * r) * c3; }
                    w[h].x = pk4_fp8(o[0][0], o[0][1], o[0][2], o[0][3]); w[h].y = pk4_fp8(o[1][0], o[1][1], o[1][2], o[1][3]); }
                const unsigned gx = odd ? w[0].x : w[1].x, gy = odd ? w[0].y : w[1].y, kx = odd ? w[1].x : w[0].x, ky = odd ? w[1].y : w[0].y;
                const unsigned rx = (unsigned)__builtin_amdgcn_ds_bpermute(partner, (int)gx), ry = (unsigned)__builtin_amdgcn_ds_bpermute(partner, (int)gy);
                u32x4 v; v.x = odd ? rx : kx; v.y = odd ? ry : ky; v.z = odd ? kx : rx; v.w = odd ? ky : ry;
                const int rl = rl0 + ai * 128 + (2 * mp + odd) * 16;
                *(u32x4*)((unsigned char*)ACT + (size_t)(u.pm * 256 + rl) * FF + (col0 - 8 * odd)) = v; }
    }
};
struct EpiG7 {
    unsigned char* PS;
    __device__ __forceinline__ bool keep(const Unit&) const { return false; }
    __device__ __forceinline__ void operator()(f32x4 (&acc)[2][2][4][2], const Unit& u, int wr, int wc, int fr, int fq) const {
        const int odd = fq & 1, lane = fr + 16 * fq, partner = (lane ^ 16) * 4;
        const unsigned off0 = (unsigned)((u.pm * 256 + wr * 64 + fr) * D + u.pn * 256 + wc * 32 + 16 * (fq >> 1) + 128 * odd);
#pragma unroll
        for (int ai = 0; ai < 2; ++ai)
#pragma unroll
            for (int m = 0; m < 4; ++m) { u32x2 w[2];
#pragma unroll
                for (int bj = 0; bj < 2; ++bj) { const f32x4 v0 = acc[ai][bj][m][0], v1 = acc[ai][bj][m][1];
                    w[bj].x = pk4_fp8(v0[0], v0[1], v0[2], v0[3]); w[bj].y = pk4_fp8(v1[0], v1[1], v1[2], v1[3]); }
                const u32x2 give = odd ? w[0] : w[1], keepv = odd ? w[1] : w[0];
                u32x2 got; got.x = (unsigned)__builtin_amdgcn_ds_bpermute(partner, (int)give.x); got.y = (unsigned)__builtin_amdgcn_ds_bpermute(partner, (int)give.y);
                u32x4 o; if (odd) { o.x = got.x; o.y = got.y; o.z = keepv.x; o.w = keepv.y; } else { o.x = keepv.x; o.y = keepv.y; o.z = got.x; o.w = got.y; }
                *(u32x4*)(PS + off0 + (unsigned)((ai * 128 + m * 16) * D)) = o; }
    }
};

constexpr int ATT_BUF = 65536, ATT_V_OFF = 32768;
__device__ __forceinline__ s16x4 vtr(const LAS unsigned char* p) { return __builtin_bit_cast(s16x4, __builtin_amdgcn_ds_read_tr16_b64_v4i16((LAS s16x4*)p)); }

__device__ __forceinline__ void attn_issue(Frame& F, int u, int bsel, const bf16* Kg, const bf16* Vg, const bf16* zeros) {
    const int kh = u & 3, n = (u >> 2) & 63, b = u >> 8, T0 = b * SEQ + n * 128, lane = F.lane;
    LAS unsigned char* base = F.lds + bsel * ATT_BUF;
#pragma unroll
    for (int j = 0; j < 4; ++j) { const int q = F.wave * 4 + j, row = 8 * q + (lane >> 3), cp = lane & 7; const bool ok = (n > 0) || (row >= 128);
        const long tok = (long)T0 - 128 + row;
        const bf16* ks = ok ? Kg + tok * KVW + kh * 64 + ((cp ^ ((row >> 1) & 7)) * 8) : zeros + lane * 8;
        const bf16* vs = ok ? Vg + tok * KVW + kh * 64 + ((cp ^ (((row >> 1) & 1) << 2)) * 8) : zeros + lane * 8;
        __builtin_amdgcn_global_load_lds((const unsigned*)ks, (LAS unsigned*)(base + q * 1024), 16, 0, 0);
        __builtin_amdgcn_global_load_lds((const unsigned*)vs, (LAS unsigned*)(base + ATT_V_OFF + q * 1024), 16, 0, 0); }
}

__device__ __forceinline__ void conv_fixup(Frame& F, const bf16* B2, const bf16* CUg, bf16* YC, const float* cw, const float* cbias) {
    if (F.wave != 0) return;
    for (int item = F.vcu; item < (M / 256) * 2; item += F.G) {
        const int pm = item >> 1, r = item & 1, t = pm * 256 + r, tseq = t & (SEQ - 1);
#pragma unroll 1
        for (int half = 0; half < 2; ++half) { const int c0 = half * 512 + F.lane * 8;
            float w0[8], w1[8], w2[8], cb[8], fc[8], f1[8], f2[8], bv[8], y[8];
#pragma unroll
            for (int q = 0; q < 8; ++q) { w0[q] = cw[c0 + q]; w1[q] = cw[D + c0 + q]; w2[q] = cw[2 * D + c0 + q]; cb[q] = cbias[c0 + q]; f1[q] = 0.f; f2[q] = 0.f; }
            const u32x4 rc = *(const u32x4*)(CUg + (size_t)t * D + c0), rb = *(const u32x4*)(B2 + (size_t)(pm * 2 + r) * D + c0);
            const u32x4 r1 = *(const u32x4*)(CUg + (size_t)(t >= 1 ? t - 1 : 0) * D + c0), r2 = *(const u32x4*)(CUg + (size_t)(t >= 2 ? t - 2 : 0) * D + c0);
            unpack8(rc, fc); unpack8(rb, bv);
            if (tseq >= 1) unpack8(r1, f1);
            if (tseq >= 2) unpack8(r2, f2);
#pragma unroll
            for (int q = 0; q < 8; ++q) y[q] = bv[q] * (w0[q] * f2[q] + w1[q] * f1[q] + w2[q] * fc[q] + cb[q]);
            u32x4 w; w.x = cvt_pk_bf16(y[0], y[1]); w.y = cvt_pk_bf16(y[2], y[3]); w.z = cvt_pk_bf16(y[4], y[5]); w.w = cvt_pk_bf16(y[6], y[7]);
            *(u32x4*)(YC + (size_t)t * D + c0) = w; }
    }
}
#define ATP_BEGIN(k) unsigned long long t_##k = 0; if (PROBE_K == (k)) t_##k = __builtin_amdgcn_s_memrealtime();
#define ATP_END(k) if (PROBE_K == (k)) span += __builtin_amdgcn_s_memrealtime() - t_##k;
__device__ __forceinline__ void attn_phase(Frame& F, bf16* QO, const bf16* Kg, const bf16* Vg, const float* sinks, const bf16* Bg, const bf16* CUg, bf16* YC, const float* cw, const float* cbias, bool fuse_conv, unsigned long long& span) {
    const int lane = F.lane, wid = F.wave, r32 = lane & 31, hi = lane >> 5;
    const bf16* zeros = (const bf16*)(F.ws + WS_CTL + 48 * 1024);
    const int NU = BATCH * (SEQ / 128) * NKV;
    const int c0 = (wid & 1) * 512 + lane * 8; const int ctok0 = F.vcu * 128 + (wid >> 1) * 32;
    LAS float* cwl = (LAS float*)(F.lds + CONVW_OFF);
    u32x4 pr1 = (u32x4){0u, 0u, 0u, 0u}, pr2 = pr1;
    if (fuse_conv) {
        for (int i = F.tid; i < 4 * D; i += NWAVES * 64) cwl[i] = (i < 3 * D) ? cw[i] : cbias[i - 3 * D];
        if ((ctok0 & (SEQ - 1)) != 0) { pr1 = *(const u32x4*)(CUg + (size_t)(ctok0 - 1) * D + c0); pr2 = *(const u32x4*)(CUg + (size_t)(ctok0 - 2) * D + c0); }
    }
    int slot = 0;
    int u = F.vcu;
    bf16x8 qf[4];
    if (u < NU) { attn_issue(F, u, 0, Kg, Vg, zeros);
        const int kh = u & 3, n = (u >> 2) & 63, b = u >> 8; const unsigned qo = (unsigned)(((b * SEQ + n * 128) + 32 * (2 * (wid & 1)) + r32) * D + (kh * 4 + (wid >> 1)) * 64 + 8 * hi) * 2u;
#pragma unroll
        for (int ks = 0; ks < 4; ++ks) qf[ks] = *(const bf16x8*)((const char*)QO + qo + 32 * ks); }
    for (int it = 0; u < NU; u += F.G, ++it) {
        const int kh = u & 3, n = (u >> 2) & 63, b = u >> 8;
        const int T0 = b * SEQ + n * 128;
        const int g = wid >> 1, head = kh * 4 + g;
        const float slope2 = __builtin_amdgcn_exp2f(-0.5f * (float)(head + 1)) * LOG2E;
        const float sink2 = sinks[head] * LOG2E;
        ATP_BEGIN(20)
        asm volatile("s_waitcnt vmcnt(0)" ::: "memory");
        __syncthreads();
        ATP_END(20)
        const bool more = (u + F.G < NU);
        if (more) attn_issue(F, u + F.G, (it + 1) & 1, Kg, Vg, zeros);
        const LAS unsigned char* Kl = F.lds + (it & 1) * ATT_BUF; const LAS unsigned char* Vl = Kl + ATT_V_OFF;
        const int kswz = (r32 >> 1) & 7;
#pragma unroll 1
        for (int p = 0; p < 2; ++p) {
            const int qs = 2 * (wid & 1) + p;
            ATP_BEGIN(21)
            const unsigned qoff = (unsigned)((T0 + 32 * qs + r32) * D + head * 64 + 4 * hi) * 2u;
            bf16x8 qn[4];
            { const int un = (p == 0) ? u : u + F.G; const int khn = un & 3, nn = (un >> 2) & 63, bn = un >> 8;
              const unsigned qno = (unsigned)(((bn * SEQ + nn * 128) + 32 * (2 * (wid & 1) + (p ^ 1)) + r32) * D + (khn * 4 + g) * 64 + 8 * hi) * 2u;
              if (p == 0 || more) {
#pragma unroll
                  for (int ks = 0; ks < 4; ++ks) qn[ks] = *(const bf16x8*)((const char*)QO + qno + 32 * ks); }
              else {
#pragma unroll
                  for (int ks = 0; ks < 4; ++ks) qn[ks] = qf[ks]; } }
            u32x4 cva[4], cvb[4];
            if (fuse_conv) {
#pragma unroll
                for (int t = 0; t < 4; ++t) { const unsigned off = (unsigned)((ctok0 + 4 * slot + t) * D + c0) * 2u; cva[t] = *(const u32x4*)((const char*)CUg + off); cvb[t] = *(const u32x4*)((const char*)Bg + off); } }
            float sl = slope2; int rl = 4 * hi - r32; asm volatile("" : "+v"(sl), "+v"(rl));
            const float base = sl * (float)(rl - 128);
            f32x16 s[5];
#pragma unroll
            for (int ti = 0; ti < 5; ++ti) { const LAS unsigned char* kb = Kl + (32 * (qs + ti) + r32) * 128;
                f32x16 a;
#pragma unroll
                for (int r = 0; r < 16; ++r) a[r] = sl * (float)(32 * ti + (r & 3) + 8 * (r >> 2)) + base;
#pragma unroll
                for (int ks = 0; ks < 4; ++ks) { const bf16x8 kf = *(const LAS bf16x8*)(kb + (((2 * ks + hi) ^ kswz) * 16)); a = __builtin_amdgcn_mfma_f32_32x32x16_bf16(kf, qf[ks], a, 0, 0, 0); }
                s[ti] = a; }
            float mx = -INFINITY;
#pragma unroll
            for (int ti = 0; ti < 5; ++ti) {
#pragma unroll
                for (int r = 0; r < 16; ++r) { const int ro = (r & 3) + 8 * (r >> 2); float v = s[ti][r];
                    const int rel0 = ro + rl;
                    if (ti == 0) v = (rel0 >= 1) ? v : -INFINITY;
                    if (ti == 4) v = (rel0 <= 0) ? v : -INFINITY;
                    s[ti][r] = v; mx = fmaxf(mx, v); } }
            if (__builtin_expect(n == 0, 0)) {
                asm volatile("" : "+v"(mx));
                mx = -INFINITY;
#pragma unroll
                for (int ti = 0; ti < 5; ++ti) { const bool dead = (qs + ti < 4);
#pragma unroll
                    for (int r = 0; r < 16; ++r) { const float v = dead ? -INFINITY : s[ti][r]; s[ti][r] = v; mx = fmaxf(mx, v); } } }
            mx = fmaxf(mx, __shfl_xor(mx, 32)); mx = fmaxf(mx, sink2);
            f32x2 sum2 = (f32x2){0.f, 0.f}; const f32x2 mx2 = (f32x2){mx, mx};
#pragma unroll
            for (int ti = 0; ti < 5; ++ti)
#pragma unroll
                for (int rp = 0; rp < 8; ++rp) { const f32x2 d = (f32x2){s[ti][2 * rp], s[ti][2 * rp + 1]} - mx2;
                    const f32x2 e = (f32x2){__builtin_amdgcn_exp2f(d.x), __builtin_amdgcn_exp2f(d.y)}; s[ti][2 * rp] = e.x; s[ti][2 * rp + 1] = e.y; sum2 += e; }
            float sum = sum2.x + sum2.y;
            sum += __shfl_xor(sum, 32);
            const float inv = 1.0f / (sum + __builtin_amdgcn_exp2f(sink2 - mx));
            f32x16 o[2]; o[0] = (f32x16){}; o[1] = (f32x16){};
            const int i16 = lane & 15, gsel = (lane >> 4) & 1;
            const int vcol = (gsel * 16 + 4 * (i16 & 3)) * 2;
            const int vswz = ((i16 >> 3) & 1) << 6;
#pragma unroll
            for (int ti = 0; ti < 5; ++ti)
#pragma unroll
                for (int s2 = 0; s2 < 2; ++s2) {
                    u32x4 pw; pw.x = cvt_pk_bf16(s[ti][8 * s2 + 0], s[ti][8 * s2 + 1]); pw.y = cvt_pk_bf16(s[ti][8 * s2 + 2], s[ti][8 * s2 + 3]);
                    pw.z = cvt_pk_bf16(s[ti][8 * s2 + 4], s[ti][8 * s2 + 5]); pw.w = cvt_pk_bf16(s[ti][8 * s2 + 6], s[ti][8 * s2 + 7]);
                    const bf16x8 pf = __builtin_bit_cast(bf16x8, pw);
                    const int key0 = 32 * (qs + ti) + 16 * s2 + 4 * hi + (i16 >> 2);
#pragma unroll
                    for (int dt = 0; dt < 2; ++dt) {
                        const LAS unsigned char* vp = Vl + key0 * 128 + ((dt * 64 + vcol) ^ vswz);
                        const s16x4 lo = vtr(vp), hh = vtr(vp + 8 * 128);
                        const bf16x8 vf = (bf16x8){lo[0], lo[1], lo[2], lo[3], hh[0], hh[1], hh[2], hh[3]};
                        o[dt] = __builtin_amdgcn_mfma_f32_32x32x16_bf16(vf, pf, o[dt], 0, 0, 0); } }
            ATP_END(21)
            ATP_BEGIN(22)
#pragma unroll
            for (int dt = 0; dt < 2; ++dt)
#pragma unroll
                for (int k = 0; k < 2; ++k) {
                    const unsigned ax = cvt_pk_bf16(o[dt][8 * k] * inv, o[dt][8 * k + 1] * inv), ay = cvt_pk_bf16(o[dt][8 * k + 2] * inv, o[dt][8 * k + 3] * inv);
                    const unsigned bx = cvt_pk_bf16(o[dt][8 * k + 4] * inv, o[dt][8 * k + 5] * inv), by = cvt_pk_bf16(o[dt][8 * k + 6] * inv, o[dt][8 * k + 7] * inv);
                    const auto r0 = __builtin_amdgcn_permlane32_swap(ax, bx, false, false), r1 = __builtin_amdgcn_permlane32_swap(ay, by, false, false);
                    u32x4 w; w.x = r0[0]; w.y = r1[0]; w.z = r0[1]; w.w = r1[1];
                    *(u32x4*)((char*)QO + (qoff - 8u * hi) + (32 * dt + 16 * k + 8 * hi) * 2) = w; }
            ATP_END(22)
            if (fuse_conv) {
                float w0[8], w1[8], w2[8], cb[8];
#pragma unroll
                for (int q = 0; q < 2; ++q) { const f32x4 a0 = *(const LAS f32x4*)(cwl + c0 + 4 * q), a1 = *(const LAS f32x4*)(cwl + D + c0 + 4 * q), a2 = *(const LAS f32x4*)(cwl + 2 * D + c0 + 4 * q), a3 = *(const LAS f32x4*)(cwl + 3 * D + c0 + 4 * q);
#pragma unroll
                    for (int e = 0; e < 4; ++e) { w0[4 * q + e] = a0[e]; w1[4 * q + e] = a1[e]; w2[4 * q + e] = a2[e]; cb[4 * q + e] = a3[e]; } }
#pragma unroll
                for (int t = 0; t < 4; ++t) { float cu[8], bv[8], y[8], p1[8], p2[8]; unpack8(cva[t], cu); unpack8(cvb[t], bv); unpack8(pr1, p1); unpack8(pr2, p2);
#pragma unroll
                    for (int q = 0; q < 8; ++q) y[q] = bv[q] * (w0[q] * p2[q] + w1[q] * p1[q] + w2[q] * cu[q] + cb[q]);
                    pr2 = pr1; pr1 = cva[t];
                    u32x4 w; w.x = cvt_pk_bf16(y[0], y[1]); w.y = cvt_pk_bf16(y[2], y[3]); w.z = cvt_pk_bf16(y[4], y[5]); w.w = cvt_pk_bf16(y[6], y[7]);
                    *(u32x4*)((char*)YC + (unsigned)((ctok0 + 4 * slot + t) * D + c0) * 2u) = w; }
                ++slot; }
#pragma unroll
            for (int ks = 0; ks < 4; ++ks) qf[ks] = qn[ks];
        }
    }
    ATP_BEGIN(23)
    asm volatile("s_waitcnt vmcnt(0)" ::: "memory");
    __syncthreads();
    ATP_END(23)
}

__device__ __forceinline__ void conv_phase(Frame& F, const bf16* Bg, const bf16* CUg, bf16* YC, const float* cw, const float* cbias) {
    const int gw = F.vcu * NWAVES + F.wave, NGW = F.G * NWAVES;
    for (int it = gw; it < (M / 32) * 2; it += NGW) {
        const int half = it & 1, t0 = (it >> 1) * 32, c0 = half * 512 + F.lane * 8;
        float w0[8], w1[8], w2[8], cb[8], p1[8], p2[8];
#pragma unroll
        for (int q = 0; q < 8; ++q) { w0[q] = cw[c0 + q]; w1[q] = cw[D + c0 + q]; w2[q] = cw[2 * D + c0 + q]; cb[q] = cbias[c0 + q]; p1[q] = 0.f; p2[q] = 0.f; }
        if ((t0 & (SEQ - 1)) != 0) {
            const u32x4 a = *(const u32x4*)(CUg + (size_t)(t0 - 1) * D + c0), c = *(const u32x4*)(CUg + (size_t)(t0 - 2) * D + c0);
            p1[0] = bflo(a.x); p1[1] = bfhi(a.x); p1[2] = bflo(a.y); p1[3] = bfhi(a.y); p1[4] = bflo(a.z); p1[5] = bfhi(a.z); p1[6] = bflo(a.w); p1[7] = bfhi(a.w);
            p2[0] = bflo(c.x); p2[1] = bfhi(c.x); p2[2] = bflo(c.y); p2[3] = bfhi(c.y); p2[4] = bflo(c.z); p2[5] = bfhi(c.z); p2[6] = bflo(c.w); p2[7] = bfhi(c.w);
        }
#pragma unroll 4
        for (int t = 0; t < 32; ++t) {
            const u32x4 a = *(const u32x4*)(CUg + (size_t)(t0 + t) * D + c0), bb = *(const u32x4*)(Bg + (size_t)(t0 + t) * D + c0);
            const float cu[8] = {bflo(a.x), bfhi(a.x), bflo(a.y), bfhi(a.y), bflo(a.z), bfhi(a.z), bflo(a.w), bfhi(a.w)};
            const float bv[8] = {bflo(bb.x), bfhi(bb.x), bflo(bb.y), bfhi(bb.y), bflo(bb.z), bfhi(bb.z), bflo(bb.w), bfhi(bb.w)};
            float y[8];
#pragma unroll
            for (int q = 0; q < 8; ++q) { y[q] = bv[q] * (w0[q] * p2[q] + w1[q] * p1[q] + w2[q] * cu[q] + cb[q]); p2[q] = p1[q]; p1[q] = cu[q]; }
            u32x4 w; w.x = pk2(y[0], y[1]); w.y = pk2(y[2], y[3]); w.z = pk2(y[4], y[5]); w.w = pk2(y[6], y[7]);
            *(u32x4*)(YC + (size_t)(t0 + t) * D + c0) = w;
        }
    }
}

__device__ __forceinline__ void router_phase(Frame& F, const bf16* X1, bf16* X1B) {
    const int lane = F.lane, wid = F.wave, tid = F.tid;
    LAS float* lg = (LAS float*)(F.lds + wid * 3072);
    LAS int* lcnt = (LAS int*)(F.lds + 24576); LAS int* lbase = lcnt + 32;
    LAS u32x4* RWL = (LAS u32x4*)(F.lds + 32768);
    bool fill = true;
    const float* bg = F.in[11]; const float* be = F.in[13];
    int* LT = (int*)(F.ws + WS_LTOK); f32x2* LRW = (f32x2*)(F.ws + WS_LR);
    for (int tb = F.vcu; tb < M / 128; tb += F.G) {
        if (tid < 32) lcnt[tid] = 0;
        const int tok0 = tb * 128 + wid * 16, row = lane & 15, kg = lane >> 4;
        const bf16* xr = X1 + (size_t)(tok0 + row) * D + 16 * kg;
        f32x4 acc[3]; acc[0] = (f32x4){0.f, 0.f, 0.f, 0.f}; acc[1] = acc[0]; acc[2] = acc[0];
        float ss = 0.f;
        const int rot = (4 * wid + 4 * tb + 3 * (tb >> 2)) & 15;
#define RT_LOAD(XA, c4) do { _Pragma("unroll") for (int q = 0; q < 4; ++q) { const int p_ = (4 * (c4) + q + rot) & 15; XA[2 * q] = *(const u32x4*)(xr + 64 * p_); XA[2 * q + 1] = *(const u32x4*)(xr + 64 * p_ + 8); } } while (0)
#define RT_COMP(XA, c4) do { _Pragma("unroll") for (int q = 0; q < 4; ++q) { const int p = (4 * (c4) + q + rot) & 15; \
            float xa[8], xb[8]; unpack8(XA[2 * q], xa); unpack8(XA[2 * q + 1], xb);     \
            _Pragma("unroll") for (int j = 0; j < 8; ++j) ss += xa[j] * xa[j] + xb[j] * xb[j]; \
            { u32x4 w8; w8.x = pk4_fp8(xa[0], xa[1], xa[2], xa[3]); w8.y = pk4_fp8(xa[4], xa[5], xa[6], xa[7]); w8.z = pk4_fp8(xb[0], xb[1], xb[2], xb[3]); w8.w = pk4_fp8(xb[4], xb[5], xb[6], xb[7]); \
              *(u32x4*)((unsigned char*)X1B + (size_t)(tok0 + row) * D + 16 * kg + 64 * p) = w8; } \
            _Pragma("unroll") for (int h = 0; h < 2; ++h) { const bf16x8 Ah = __builtin_bit_cast(bf16x8, XA[2 * q + h]); \
                _Pragma("unroll") for (int t = 0; t < 3; ++t) { \
                    const bf16x8 Bh = __builtin_bit_cast(bf16x8, RWL[((2 * p + h) * 3 + t) * 64 + lane]); \
                    acc[t] = __builtin_amdgcn_mfma_f32_16x16x32_bf16(Ah, Bh, acc[t], 0, 0, 0); } } } } while (0)
        { u32x4 xa0[8], xa1[8];
          RT_LOAD(xa0, 0);
          if (fill) { const u32x4* RWF = (const u32x4*)(F.ws + WS_RWF); fill = false;
              for (int i = tid; i < 96 * 64; i += NWAVES * 64) RWL[i] = RWF[(size_t)(i >> 6) * 128 + (i & 63)]; }
          __syncthreads();
#pragma unroll 1
          for (int c4 = 0; c4 < 4; c4 += 2) {
              RT_LOAD(xa1, c4 + 1);
              RT_COMP(xa0, c4);
              if (c4 + 2 < 4) RT_LOAD(xa0, c4 + 2);
              RT_COMP(xa1, c4 + 1);
          } }
#undef RT_LOAD
#undef RT_COMP
#pragma unroll
        for (int t = 0; t < 3; ++t)
#pragma unroll
            for (int i = 0; i < 4; ++i) lg[(4 * kg + i) * 48 + 16 * t + row] = acc[t][i];
        ss += __shfl_xor(ss, 16); ss += __shfl_xor(ss, 32);
        const float rr = 1.0f / sqrtf(ss * (1.f / D) + EPS);
        LDS_WAIT(); asm volatile("" ::: "memory");
        int e0 = 0, e1 = 0, rank0 = 0, rank1 = 0; float w0 = 0.f, w1 = 0.f;
        if (lane < 16) {
            const LAS float* my = lg + lane * 48;
            float gl[4];
#pragma unroll
            for (int j = 0; j < 4; ++j) gl[j] = rr * my[j] + bg[j];
            int gi = 0; float gm = gl[0];
#pragma unroll
            for (int j = 1; j < 4; ++j) if (gl[j] > gm) { gm = gl[j]; gi = j; }
            float den = 0.f;
#pragma unroll
            for (int j = 0; j < 4; ++j) den += __expf(gl[j] - gm);
            const float pg = 1.0f / den;
            float v0 = -INFINITY, v1 = -INFINITY; int i0 = 0, i1 = 0;
#pragma unroll
            for (int i = 0; i < 8; ++i) { const float v = rr * my[4 + 8 * gi + i] + be[8 * gi + i];
                if (v > v0) { v1 = v0; i1 = i0; v0 = v; i0 = i; } else if (v > v1) { v1 = v; i1 = i; } }
            const float ex = __expf(v1 - v0), s0 = 1.0f / (1.0f + ex);
            w0 = pg * s0; w1 = pg * (ex * s0);
            e0 = 8 * gi + i0; e1 = 8 * gi + i1;
            rank0 = __hip_atomic_fetch_add(lcnt + e0, 1, __ATOMIC_RELAXED, __HIP_MEMORY_SCOPE_WORKGROUP); rank1 = __hip_atomic_fetch_add(lcnt + e1, 1, __ATOMIC_RELAXED, __HIP_MEMORY_SCOPE_WORKGROUP);
        }
        __syncthreads();
        if (tid < 32) { const int c = lcnt[tid]; int bs = 0; if (c > 0) bs = (int)__hip_atomic_fetch_add((unsigned*)(F.ctl + CW_CNT + 64 * tid), (unsigned)c, RLX_AGENT); lbase[tid] = bs; }
        __syncthreads();
        if (lane < 16) { const int tok = tok0 + lane;
            const int p0 = e0 * CAP + lbase[e0] + rank0, p1 = e1 * CAP + lbase[e1] + rank1;
            const int q0 = (p0 & ~255) + (((((p0 >> 7) & 1) * 2 + ((p0 >> 6) & 1)) * 16 + (p0 & 15)) << 2) + ((p0 >> 4) & 3), q1 = (p1 & ~255) + (((((p1 >> 7) & 1) * 2 + ((p1 >> 6) & 1)) * 16 + (p1 & 15)) << 2) + ((p1 >> 4) & 3);
            LT[p0] = tok * 2; LRW[q0] = (f32x2){rr, w0};
            LT[p1] = tok * 2 + 1; LRW[q1] = (f32x2){rr, w1};
            *(int2*)((int*)(F.ws + WS_POS) + 2 * tok) = make_int2(p0, p1); }
        __syncthreads();
    }
}

__device__ __forceinline__ void final_phase(Frame& F, const bf16* X1, const unsigned char* PAIRS, const float* g, float* OUT, const int* POS, const LAS int* pfx) {
    const int gw = F.vcu * NWAVES + F.wave, NGW = F.G * NWAVES;
    const int lane = (int)__builtin_amdgcn_mbcnt_hi(~0u, __builtin_amdgcn_mbcnt_lo(~0u, 0u));
    float gf[2][8];
#pragma unroll
    for (int j = 0; j < 2; ++j)
#pragma unroll
        for (int q = 0; q < 8; ++q) gf[j][q] = g[512 * j + 8 * lane + q];
    int2 pnx = *(const int2*)(POS + 2 * (gw < M ? gw : 0));
    for (int m = gw; m < M; m += NGW) {
        const int2 pc = pnx; { const int mn = (m + NGW < M) ? m + NGW : m; pnx = *(const int2*)(POS + 2 * mn); }
        const int q0 = __builtin_amdgcn_readfirstlane(pc.x), q1 = __builtin_amdgcn_readfirstlane(pc.y);
        const size_t r0 = (size_t)(256 * pfx[q0 >> 15] + (q0 & (CAP - 1))), r1 = (size_t)(256 * pfx[q1 >> 15] + (q1 & (CAP - 1)));
        u32x4 hv[2]; u32x2 pa[2], pb[2];
#pragma unroll
        for (int j = 0; j < 2; ++j) { const unsigned c = 512 * j + 8 * lane;
            hv[j] = *(const u32x4*)(X1 + (size_t)m * D + c);
            pa[j] = *(const u32x2*)(PAIRS + r0 * D + c); pb[j] = *(const u32x2*)(PAIRS + r1 * D + c); }
        float v[2][8]; float s = 0.f;
#pragma unroll
        for (int j = 0; j < 2; ++j) { float hx[8]; unpack8(hv[j], hx);
            const f32x2 a0 = __builtin_amdgcn_cvt_pk_f32_fp8((int)pa[j].x, false), a1 = __builtin_amdgcn_cvt_pk_f32_fp8((int)pa[j].x, true), a2 = __builtin_amdgcn_cvt_pk_f32_fp8((int)pa[j].y, false), a3 = __builtin_amdgcn_cvt_pk_f32_fp8((int)pa[j].y, true);
            const f32x2 b0 = __builtin_amdgcn_cvt_pk_f32_fp8((int)pb[j].x, false), b1 = __builtin_amdgcn_cvt_pk_f32_fp8((int)pb[j].x, true), b2 = __builtin_amdgcn_cvt_pk_f32_fp8((int)pb[j].y, false), b3 = __builtin_amdgcn_cvt_pk_f32_fp8((int)pb[j].y, true);
            const float pp[8] = {a0.x + b0.x, a0.y + b0.y, a1.x + b1.x, a1.y + b1.y, a2.x + b2.x, a2.y + b2.y, a3.x + b3.x, a3.y + b3.y};
#pragma unroll
            for (int q = 0; q < 8; ++q) { const float x = hx[q] + pp[q] * (1.0f / P8_SCALE); v[j][q] = x; s += x * x; } }
        const float rs = 1.0f / sqrtf(wave_sum(s) * (1.f / D) + EPS);
#pragma unroll
        for (int j = 0; j < 2; ++j) { float* o = OUT + (size_t)m * D + 512 * j + 8 * lane;
            __builtin_nontemporal_store((f32x4){v[j][0] * rs * gf[j][0], v[j][1] * rs * gf[j][1], v[j][2] * rs * gf[j][2], v[j][3] * rs * gf[j][3]}, (f32x4*)o);
            __builtin_nontemporal_store((f32x4){v[j][4] * rs * gf[j][4], v[j][5] * rs * gf[j][5], v[j][6] * rs * gf[j][6], v[j][7] * rs * gf[j][7]}, (f32x4*)(o + 4)); }
    }
}

constexpr unsigned FILL_NCH = FILL_N0 + (unsigned)(N_CVT_ITEMS - N_CVT_P0 - N_SIDE_ITEMS) / 8u;
__device__ __forceinline__ unsigned filler_claim(Frame& F) { return __hip_atomic_fetch_add((unsigned*)(F.ctl + CW_FILL), 1u, __ATOMIC_RELAXED, __HIP_MEMORY_SCOPE_AGENT); }
__device__ __forceinline__ unsigned filler_hold(Frame& F) {
    unsigned h = F.MISC[21];
    __syncthreads();
    if (h == 0u) { if (F.tid == 0) F.MISC[21] = 1u + filler_claim(F); __syncthreads(); h = F.MISC[21]; __syncthreads(); }
    return h - 1u;
}
__device__ __forceinline__ void filler_work(Frame& F, unsigned c) {
    const CvtItem ci = cvt_decode(F, I_IN + N_SIDE_ITEMS + (int)c * 8 + F.wave);
    f32x4 v[8]; CvtGain gg; cvt_load(ci, F.lane, v, gg); cvt_store(ci, F.lane, v, gg);
    if (F.tid == 0) F.MISC[21] = 0u;
    __syncthreads();
}
__device__ __forceinline__ void filler_drain(Frame& F, unsigned limit) {
    for (;;) { const unsigned c = filler_hold(F); if (c >= limit) break; filler_work(F, c); }
}
__device__ __forceinline__ void xcd_barrier_fill(const XcdBarrier& b, int s, Frame& F) {
    asm volatile("s_waitcnt vmcnt(0)" ::: "memory");
    xcd_split_arrive(b, s);
    bool more = (N_LAUNCHES == 1); unsigned sp = 0;
    for (;;) {
        if (F.tid == 0) {
            unsigned h = F.MISC[21]; unsigned cl = 0u;
            if (h == 0u && more) cl = 1u + filler_claim(F);
            const unsigned g = xb_ld(&b.bar[XS_GEN(s)]) | xb_ld(&b.bar[XB_TMO]);
            if (h == 0u) F.MISC[21] = cl;
            F.MISC[17] = g; }
        __syncthreads();
        const unsigned g = F.MISC[17], h = F.MISC[21];
        __syncthreads();
        if (g != 0u) break;
        if (h != 0u && h - 1u < FILL_NCH) filler_work(F, h - 1u);
        else { more = more && (h == 0u); __builtin_amdgcn_s_sleep(4); if (++sp > XB_SPIN_CAP) { if (F.tid == 0) atomicAdd(&b.bar[XB_TMO], 1u); break; } }
    }
    if (F.tid == 0) { __builtin_amdgcn_fence(__ATOMIC_ACQUIRE, "agent"); asm volatile("s_waitcnt vmcnt(0)" ::: "memory"); }
    __syncthreads();
}

struct Args { const float* in[18]; float* out; unsigned char* ws; int ph_lo, ph_hi; };
__global__ void __launch_bounds__(NWAVES * 64, 2) mk_fwd(Args args) {
    extern __shared__ __attribute__((aligned(16))) unsigned char lds[];
    Frame F;
    F.lds = (LAS unsigned char*)lds;
    F.MISC = (volatile LAS unsigned*)(F.lds + MISC_OFF);
    F.tid = threadIdx.x; F.lane = F.tid & 63; F.wave = __builtin_amdgcn_readfirstlane(F.tid >> 6);
    F.G = gridDim.x; { const int bx = blockIdx.x; F.vcu = (F.G % 8 == 0) ? (bx % 8) * (F.G / 8) + bx / 8 : bx; }
    F.ws = args.ws; F.outb = (unsigned char*)args.out; F.ctl = (gu32*)(args.ws + WS_CTL);
    F.in = (const float* const __attribute__((address_space(4)))*)__builtin_amdgcn_kernarg_segment_ptr();
    for (int u = F.tid; u < 1024 / 4; u += NWAVES * 64) ((LAS unsigned*)(F.lds + LDSCTL_OFF))[u] = 0u;
    __syncthreads();
    XcdBarrier bar; bar.bar = (unsigned*)(F.ctl + CW_BAR); bar.x = 0; bar.st = nullptr;
    if (N_LAUNCHES == 1) bar = xcd_barrier_post((unsigned*)(F.ctl + CW_BAR), F.MISC + 8);
    const int lo = args.ph_lo, hi = args.ph_hi;
#define IN(k) (lo <= (k) && (k) < hi)
#define BOTH(k) (IN(k) && IN((k) + 1))
#define GRID_BAR() xcd_barrier(bar)
    unsigned long long tprev = 0, span = 0;
    if (PROBE_K >= 0) tprev = __builtin_amdgcn_s_memrealtime();
#define STAMP(k) do { if (PROBE_K >= 0) { const unsigned long long now_ = __builtin_amdgcn_s_memrealtime(); if (PROBE_K == (k)) span = now_ - tprev; tprev = now_; } } while (0)

    bf16* H = (bf16*)(F.ws + WS_H); bf16* Bb = (bf16*)(F.ws + WS_B); bf16* CUb = (bf16*)(F.ws + WS_CU);
    bf16* Kb = (bf16*)(F.ws + WS_K); bf16* Vb = (bf16*)(F.ws + WS_V); bf16* GBb = (bf16*)(F.ws + WS_GB);
    bf16* QO = (bf16*)F.outb; bf16* GAb = (bf16*)(F.outb + 64 * MiB);
    bf16* X1B = (bf16*)(F.ws + WS_X1B); unsigned char* ACT8 = F.ws + WS_ACT; const float* RI = (const float*)(F.ws + WS_RI);
    const LAS int* pfx = (const LAS int*)(F.lds + PFX_OFF);

    if (IN(0)) { p0_prologue(F);
        if (BOTH(0)) { if (USE_CG_SYNC) { VM_WAIT(); cg::this_grid().sync(); }
            else { GRID_BAR();
                   if (__builtin_amdgcn_readfirstlane((int)xb_ld(bar.bar + XB_TMO)) != 0) { VM_WAIT(); cg::this_grid().sync(); } } } }
    STAMP(0);

    if (IN(1)) {
        { LAS float* cwl = (LAS float*)(F.lds + CONVW_OFF); const float* cw = F.in[3]; const float* cbias = F.in[4];
          for (int i = F.tid; i < 4 * D; i += NWAVES * 64) cwl[i] = (i < 3 * D) ? cw[i] : cbias[i - 3 * D]; }
        __syncthreads();
        SchedG1 S{(const char*)H, (const char*)(F.ws + WS_WIN), (int)blockIdx.x};
        EpiG1 E{Bb, CUb, QO, Kb, Vb, GAb, GBb, (bf16*)(F.ws + WS_B2), &F, F.G, (int)blockIdx.x, bar, BOTH(1)};
        pg8::gemm_phase<EpiG1, SchedG1, false>(F.lds, D, S, E);
        if (BOTH(1)) { xcd_split_arrive(bar, 1);
                       xcd_split_wait(bar, 0); }
    }
    STAMP(1);
    if (IN(2)) {
        const bool fuse_conv = false;
        attn_phase(F, QO, Kb, Vb, F.in[6], Bb, CUb, H, F.in[3], F.in[4], fuse_conv, span);
        if (BOTH(1)) xcd_split_wait(bar, 1);
        conv_fixup(F, (const bf16*)(F.ws + WS_B2), CUb, Bb, F.in[3], F.in[4]);
        STAMP(2);
        filler_drain(F, FILL_N0);
        if (BOTH(2)) xcd_barrier_fill(bar, 2, F);
    }
    STAMP(3);
    if (IN(3)) {
        SchedDual S{(const char*)Bb, (long)((const char*)QO - (const char*)Bb), (const char*)(F.ws + WS_WA), (long)(WS_WB - WS_WA), M / 256, D / 256, F.G, (int)blockIdx.x};
        EpiG3 E{GAb, GBb, CUb};
        pg8::gemm_phase<EpiG3, SchedDual, false>(F.lds, D, S, E);
        if (BOTH(3)) xcd_barrier_fill(bar, 3, F);
    }
    STAMP(4);
    if (IN(4)) {
        SchedPlain S{(const char*)CUb, (const char*)(F.ws + WS_WO), M / 256, D / 256, F.G, (int)blockIdx.x, TSTEP1024};
        EpiG4 E{H, RI, F.in[1], Bb};
        pg8::gemm_phase<EpiG4, SchedPlain, false>(F.lds, D, S, E);
        if (BOTH(4)) xcd_barrier_fill(bar, 4, F);
    }
    STAMP(5);
    if (IN(5)) { router_phase(F, Bb, X1B);
        filler_drain(F, FILL_NA);
        if (BOTH(5)) xcd_barrier_fill(bar, 5, F); }
    STAMP(6);
    if (IN(6) || IN(7)) {
        if (F.tid < 32) { LAS int* p = (LAS int*)(F.lds + PFX_OFF); const int e = F.tid;
            const int c = (int)__hip_atomic_load((unsigned*)(F.ctl + CW_CNT + 64 * e), RLX_AGENT);
            const int nt = (c + 255) >> 8; int incl = nt;
#pragma unroll
            for (int o = 1; o < 32; o <<= 1) { const int up = __shfl_up(incl, o, 64); if (e >= o) incl += up; }
            const int run = incl - nt;
            p[e] = run; p[40 + e] = c;
            for (int t = 0; t < nt; ++t) p[T2E_OFF_WORDS + run + t] = e;
            if (e == 31) p[32] = incl; }
        __syncthreads();
    }
    if (IN(6)) {
        SchedMoE S{(const char*)X1B, (const char*)(F.ws + WS_WGU), pfx, (const int*)(F.ws + WS_LTOK), F.G, (int)blockIdx.x, D  , 0, (size_t)D * D, (size_t)256 * D, true};
        EpiG6 E{(const f32x2*)(F.ws + WS_LR), (bf16*)ACT8};
        pg8::gemm_phase<EpiG6, SchedMoE, true, true>(F.lds, D, S, E, 127, W8_E8M0);
        filler_drain(F, FILL_NCH);
        if (BOTH(6)) { VM_WAIT(); xcd_split_arrive(bar, 6); xcd_split_wait(bar, 6); }
    }
    STAMP(7);
    if (IN(7)) {
        SchedMoE S{(const char*)ACT8, (const char*)(F.ws + WS_WD), pfx, (const int*)(F.ws + WS_LTOK), F.G, (int)blockIdx.x, FF, (size_t)256 * FF, (size_t)D * FF, (size_t)256 * FF, false};
        EpiG7 E{(unsigned char*)GBb};
        pg8::gemm_phase<EpiG7, SchedMoE, false, true>(F.lds, FF, S, E, A8_E8M0 + 4  , W8_E8M0);
        if (BOTH(7)) { VM_WAIT(); xcd_split_arrive(bar, 7); xcd_split_wait(bar, 7); }
    }
    STAMP(8);
    if (IN(8)) {
        if (N_LAUNCHES != 1) {
            if (F.tid == 0) { LAS int* p = (LAS int*)(F.lds + PFX_OFF); int run = 0;
                for (int e = 0; e < NEXP; ++e) { const int c = (int)__hip_atomic_load((unsigned*)(F.ctl + CW_CNT + 64 * e), RLX_AGENT); p[e] = run; p[40 + e] = c; run += (c + 255) >> 8; }
                p[32] = run; }
            __syncthreads(); }
        final_phase(F, Bb, (const unsigned char*)GBb, F.in[17], (float*)F.outb, (const int*)(F.ws + WS_POS), pfx);
    }
    STAMP(9);
    if (PROBE_K >= 0) { const unsigned long long tgt = __builtin_amdgcn_s_memrealtime() + PROBE_MULT * span; while (__builtin_amdgcn_s_memrealtime() < tgt) __builtin_amdgcn_s_sleep(16); }
#undef IN
#undef BOTH
#undef GRID_BAR
}

extern "C" void kernel_launch(void* const* d_in, const int* in_sizes, int n_in, void* d_out, int out_size, void* d_ws, size_t ws_size, hipStream_t stream) {
    static int grid = 0;
    if (grid == 0) {
        if (n_in != 18 || in_sizes[0] != M * D || out_size != M * D || ws_size < WS_END) { fprintf(stderr, "kernel_launch: unexpected shapes (n_in %d, ws %zu)\n", n_in, ws_size); grid = -1; return; }
        int dev = 0, cus = 0, per_cu = 0;
        if (hipGetDevice(&dev) != hipSuccess || hipDeviceGetAttribute(&cus, hipDeviceAttributeMultiprocessorCount, dev) != hipSuccess) { grid = -1; return; }
        if (hipFuncSetAttribute((const void*)mk_fwd, hipFuncAttributeMaxDynamicSharedMemorySize, LDS_BYTES) != hipSuccess) { fprintf(stderr, "kernel_launch: hipFuncSetAttribute failed\n"); grid = -1; return; }
        if (hipOccupancyMaxActiveBlocksPerMultiprocessor(&per_cu, (const void*)mk_fwd, NWAVES * 64, LDS_BYTES) != hipSuccess || per_cu < 1) { fprintf(stderr, "kernel_launch: occupancy query says %d\n", per_cu); (void)hipGetLastError(); grid = -1; return; }
        if (per_cu > 1) per_cu = 1;
        grid = cus * per_cu;
        if (grid != 256) { fprintf(stderr, "kernel_launch: this build's P1 unit order needs a grid of exactly 256 workgroups (one per CU of a 256-CU device); got %d\n", grid); grid = -1; return; }
    }
    if (grid < 0) return;
    (void)hipMemsetAsync((char*)d_ws + WS_CTL, 0, CTL_ZERO_BYTES, stream);
    Args a{};
    for (int i = 0; i < 18; ++i) a.in[i] = (const float*)d_in[i];
    a.out = (float*)d_out; a.ws = (unsigned char*)d_ws;
    if (N_LAUNCHES == 1) {
        a.ph_lo = 0; a.ph_hi = N_PHASES;
        void* kargs[] = {&a};
        hipError_t e = hipLaunchCooperativeKernel((const void*)mk_fwd, dim3(grid), dim3(NWAVES * 64), kargs, LDS_BYTES, stream);
        if (e != hipSuccess) fprintf(stderr, "kernel_launch: cooperative launch failed: %s (grid %d)\n", hipGetErrorString(e), grid);
    } else {
        for (int li = 0; li < N_PHASES; ++li) { a.ph_lo = li; a.ph_hi = li + 1;
            hipLaunchKernelGGL(mk_fwd, dim3(grid), dim3(NWAVES * 64), LDS_BYTES, stream, a); }
    }
}
```
